# Optimizing an MI355X kernel written in HIP

```python
import math
import jax, jax.numpy as jnp
from jax import lax
import numpy as np

D_MODEL = 1024
BATCH = 32
SEQ = 2048
DEPTH = 2

N_HEADS = 8
HEAD_DIM = D_MODEL // N_HEADS
ROT_DIM = HEAD_DIM // 4
ROPE_THETA = 500000.0
D_FF = ((8 * D_MODEL // 3 + 255) // 256) * 256
MOBA_BLOCK = 256
MOBA_TOPK = 3
MOBA_Q_CHUNK = 64
SB_Q_BLOCK = 128
N_A_LAYERS = DEPTH // 2
N_B_LAYERS = DEPTH - N_A_LAYERS
DEEPNORM_ALPHA = (2.0 * DEPTH) ** 0.25
DEEPNORM_BETA = (8.0 * DEPTH) ** -0.25
LN_EPS = 1e-5
N_SUB = 3
NEG_INF = -1e30

kernel_name = 'yoco_moba_stickbreak_macaron_deepnorm_adaln'


def layer_norm(x, g, b):
    xf = x.astype(jnp.float32)
    mu = jnp.mean(xf, axis=-1, keepdims=True)
    var = jnp.mean(jnp.square(xf - mu), axis=-1, keepdims=True)
    return ((xf - mu) * lax.rsqrt(var + LN_EPS) * g.astype(jnp.float32) + b.astype(jnp.float32)).astype(x.dtype)


def modulate(x, shift, scale):
    return x * (1.0 + scale[:, None, :]) + shift[:, None, :]


def post_norm_residual(x, y, gate, weight, g, b):
    return layer_norm(DEEPNORM_ALPHA * x + weight * (1.0 + gate[:, None, :]) * y, g, b)


def swiglu(h, w_in, w_out):
    g, u = jnp.split(h @ w_in, 2, axis=-1)
    return (jax.nn.silu(g) * u) @ w_out


def split_heads(t):
    b, s, _ = t.shape
    return t.reshape(b, s, N_HEADS, HEAD_DIM).transpose(0, 2, 1, 3)


def merge_heads(t):
    b, h, s, d = t.shape
    return t.transpose(0, 2, 1, 3).reshape(b, s, h * d)


def partial_rotary(t, pos):
    half = ROT_DIM // 2
    inv_freq = jnp.power(ROPE_THETA, -jnp.arange(half, dtype=jnp.float32) * 2.0 / ROT_DIM)
    ang = pos.astype(jnp.float32)[:, None] * inv_freq[None, :]
    cos = jnp.cos(ang)[None, None]
    sin = jnp.sin(ang)[None, None]
    tr = t[..., :ROT_DIM].astype(jnp.float32)
    t1, t2 = tr[..., :half], tr[..., half:]
    rot = jnp.concatenate([t1 * cos - t2 * sin, t2 * cos + t1 * sin], axis=-1).astype(t.dtype)
    return jnp.concatenate([rot, t[..., ROT_DIM:]], axis=-1)


def _moba_one_sequence(q_b, kb_b, vb_b, idx_b, k_own_b, v_own_b, own_mask, scale):
    h, qc, n_sel = idx_b.shape
    heads = jnp.arange(h)[:, None, None]
    kg = kb_b[heads, idx_b]
    vg = vb_b[heads, idx_b]
    s_sel = jnp.einsum('hqd,hqjkd->hqjk', q_b, kg).reshape(h, qc, -1).astype(jnp.float32) * scale
    s_own = jnp.einsum('hqd,hkd->hqk', q_b, k_own_b).astype(jnp.float32) * scale
    s_own = jnp.where(own_mask[None], s_own, NEG_INF)
    p = jax.nn.softmax(jnp.concatenate([s_sel, s_own], axis=-1), axis=-1).astype(vg.dtype)
    n_k = n_sel * MOBA_BLOCK
    p_sel = p[..., :n_k].reshape(h, qc, n_sel, MOBA_BLOCK)
    p_own = p[..., n_k:]
    return (jnp.einsum('hqjk,hqjkd->hqd', p_sel, vg)
            + jnp.einsum('hqk,hkd->hqd', p_own, v_own_b))


def moba_attention(q, k, v):
    b, h, s, dh = q.shape
    scale = dh ** -0.5
    n_full = s // MOBA_BLOCK
    kbar = k[:, :, :n_full * MOBA_BLOCK].reshape(b, h, n_full, MOBA_BLOCK, dh).astype(jnp.float32).mean(axis=3)
    outs = []
    for t0 in range(0, s, MOBA_Q_CHUNK):
        cur = t0 // MOBA_BLOCK
        own_lo = cur * MOBA_BLOCK
        own_hi = min(own_lo + MOBA_BLOCK, s)
        q_c = q[:, :, t0:t0 + MOBA_Q_CHUNK]
        k_own = k[:, :, own_lo:own_hi]
        v_own = v[:, :, own_lo:own_hi]
        own_mask = (own_lo + jnp.arange(own_hi - own_lo))[None, :] <= (t0 + jnp.arange(MOBA_Q_CHUNK))[:, None]
        n_sel = min(MOBA_TOPK, cur)
        if n_sel == 0:
            sc = jnp.einsum('bhqd,bhkd->bhqk', q_c, k_own).astype(jnp.float32) * scale
            p = jax.nn.softmax(jnp.where(own_mask[None, None], sc, NEG_INF), axis=-1).astype(v.dtype)
            outs.append(jnp.einsum('bhqk,bhkd->bhqd', p, v_own))
        else:
            gate = jnp.einsum('bhqd,bhnd->bhqn', q_c.astype(jnp.float32), kbar[:, :, :cur])
            _, idx = lax.top_k(gate, n_sel)
            kb = k[:, :, :cur * MOBA_BLOCK].reshape(b, h, cur, MOBA_BLOCK, dh)
            vb = v[:, :, :cur * MOBA_BLOCK].reshape(b, h, cur, MOBA_BLOCK, dh)
            o = lax.map(lambda a: _moba_one_sequence(a[0], a[1], a[2], a[3], a[4], a[5], own_mask, scale),
                        (q_c, kb, vb, idx, k_own, v_own))
            outs.append(o)
    return jnp.concatenate(outs, axis=2)


def stick_breaking_attention(q, k, v):
    b, h, s, dh = q.shape
    scale = dh ** -0.5
    outs = []
    for t0 in range(0, s, SB_Q_BLOCK):
        t1 = t0 + SB_Q_BLOCK
        z = jnp.einsum('bhqd,bhkd->bhqk', q[:, :, t0:t1], k[:, :, :t1]).astype(jnp.float32) * scale
        strict = jnp.arange(t1)[None, :] < (t0 + jnp.arange(SB_Q_BLOCK))[:, None]
        log_keep = jnp.where(strict, jax.nn.log_sigmoid(-z), 0.0)
        log_after = lax.cumsum(log_keep, axis=3, reverse=True) - log_keep
        w = jnp.where(strict, jnp.exp(jax.nn.log_sigmoid(z) + log_after), 0.0)
        outs.append(jnp.einsum('bhqk,bhkd->bhqd', w.astype(v.dtype), v[:, :, :t1]))
    return jnp.concatenate(outs, axis=2)


def setup_inputs(seed: int = 0) -> dict:
    key = jax.random.key(seed)
    ks = jax.random.split(key, 14)
    d, f = D_MODEL, D_FF
    nrm = jax.random.normal
    return {
        'x': nrm(ks[0], (BATCH, SEQ, d), jnp.float32),
        'c': nrm(ks[1], (BATCH, d), jnp.float32),
        'w_ada': nrm(ks[2], (DEPTH, d, 3 * N_SUB * d), jnp.float32) * (0.1 * d ** -0.5),
        'b_ada': nrm(ks[3], (DEPTH, 3 * N_SUB * d), jnp.float32) * 0.01,
        'ln_g': 1.0 + 0.02 * nrm(ks[4], (DEPTH, N_SUB, d), jnp.float32),
        'ln_b': 0.02 * nrm(ks[5], (DEPTH, N_SUB, d), jnp.float32),
        'w_ffn_in': nrm(ks[6], (DEPTH, 2, d, 2 * f), jnp.float32) * d ** -0.5,
        'w_ffn_out': nrm(ks[7], (DEPTH, 2, f, d), jnp.float32) * (f ** -0.5 * DEEPNORM_BETA),
        'w_qkv_a': nrm(ks[8], (N_A_LAYERS, d, 3 * d), jnp.float32) * d ** -0.5,
        'w_q_b': nrm(ks[9], (N_B_LAYERS, d, d), jnp.float32) * d ** -0.5,
        'w_kv_ada': nrm(ks[10], (d, 2 * d), jnp.float32) * (0.1 * d ** -0.5),
        'b_kv_ada': nrm(ks[11], (2 * d,), jnp.float32) * 0.01,
        'w_kv_b': nrm(ks[12], (d, 2 * d), jnp.float32) * d ** -0.5,
        'w_o': nrm(ks[13], (DEPTH, d, d), jnp.float32) * (d ** -0.5 * DEEPNORM_BETA),
    }


def reference(x, c, w_ada, b_ada, ln_g, ln_b, w_ffn_in, w_ffn_out, w_qkv_a, w_q_b,
              w_kv_ada, b_kv_ada, w_kv_b, w_o):
    b, s, d = x.shape
    pos = jnp.arange(s)
    cond = jax.nn.silu(c)
    k_sh = None
    v_sh = None
    for l in range(DEPTH):
        if l == N_A_LAYERS:
            kv_mod = (cond @ w_kv_ada + b_kv_ada).reshape(b, 2, d)
            kv = modulate(x, kv_mod[:, 0], kv_mod[:, 1]) @ w_kv_b
            k_sh, v_sh = jnp.split(kv, 2, axis=-1)
            k_sh = split_heads(k_sh)
            v_sh = split_heads(v_sh)
        mod = (cond @ w_ada[l] + b_ada[l]).reshape(b, 3 * N_SUB, d)
        h = modulate(x, mod[:, 0], mod[:, 1])
        x = post_norm_residual(x, swiglu(h, w_ffn_in[l, 0], w_ffn_out[l, 0]), mod[:, 2], 0.5, ln_g[l, 0], ln_b[l, 0])
        h = modulate(x, mod[:, 3], mod[:, 4])
        if l < N_A_LAYERS:
            q, k, v = jnp.split(h @ w_qkv_a[l], 3, axis=-1)
            q = partial_rotary(split_heads(q), pos)
            k = partial_rotary(split_heads(k), pos)
            y = moba_attention(q, k, split_heads(v))
        else:
            q = split_heads(h @ w_q_b[l - N_A_LAYERS])
            y = stick_breaking_attention(q, k_sh, v_sh)
        y = merge_heads(y) @ w_o[l]
        x = post_norm_residual(x, y, mod[:, 5], 1.0, ln_g[l, 1], ln_b[l, 1])
        h = modulate(x, mod[:, 6], mod[:, 7])
        x = post_norm_residual(x, swiglu(h, w_ffn_in[l, 1], w_ffn_out[l, 1]), mod[:, 8], 0.5, ln_g[l, 2], ln_b[l, 2])
    return x
```

```cpp
#include <hip/hip_runtime.h>
#include <hip/hip_cooperative_groups.h>
#include <cstdio>
namespace cg = cooperative_groups;

#define LAS __attribute__((address_space(3)))
#define DI __device__ __forceinline__
typedef unsigned short bf16_t;
typedef short bf16x8 __attribute__((ext_vector_type(8)));
typedef short s16x4 __attribute__((ext_vector_type(4)));
typedef float f32x4 __attribute__((ext_vector_type(4)));
typedef float f32x2 __attribute__((ext_vector_type(2)));
typedef float f32x16 __attribute__((ext_vector_type(16)));
typedef unsigned u32x4 __attribute__((ext_vector_type(4)));
typedef unsigned u32x2 __attribute__((ext_vector_type(2)));
typedef __bf16 bf16x2_t __attribute__((ext_vector_type(2)));

constexpr int T_TOK = 65536, DM = 1024, DFF = 2816, SEQ = 2048, NB = 32, NH = 8;
constexpr float DN_ALPHA = 1.4142135623730951f;
constexpr float LN_EPS = 1e-5f;

constexpr size_t WS_WIN   = 0;
constexpr size_t WS_WOUT  = WS_WIN  + 4ull * 5632 * 1024 * 2;
constexpr size_t WS_WQKV  = WS_WOUT + 4ull * 1024 * 2816 * 2;
constexpr size_t WS_WQB   = WS_WQKV + 3072ull * 1024 * 2;
constexpr size_t WS_WKVB  = WS_WQB  + 1024ull * 1024 * 2;
constexpr size_t WS_WO    = WS_WKVB + 2048ull * 1024 * 2;
constexpr size_t WS_MOD   = WS_WO   + 2ull * 1024 * 1024 * 2;
constexpr size_t WS_KVMOD = WS_MOD  + 2ull * 32 * 9216 * 4;
constexpr size_t WS_ROT   = WS_KVMOD + 32ull * 2048 * 4;
constexpr size_t WS_KPART = WS_ROT  + 2ull * 2048 * 16 * 4;
constexpr size_t WS_HB    = WS_KPART + 256ull * 2 * 1024 * 4;
constexpr size_t WS_QB    = WS_HB   + (size_t)T_TOK * DM * 2;
constexpr size_t WS_KB    = WS_QB   + (size_t)T_TOK * DM * 2;
constexpr size_t WS_VT    = WS_KB   + (size_t)T_TOK * DM * 2;
constexpr size_t WS_ACT   = WS_VT   + (size_t)T_TOK * DM * 2;
constexpr size_t WS_END   = WS_ACT  + (size_t)T_TOK * DFF * 2;

struct Params {
    const float* x; const float* c; const float* w_ada; const float* b_ada; const float* ln_g; const float* ln_b;
    const float* w_ffn_in; const float* w_ffn_out; const float* w_qkv_a; const float* w_q_b; const float* w_kv_ada; const float* b_kv_ada;
    const float* w_kv_b; const float* w_o; float* out; unsigned char* ws;
};

DI int opaque_tid() { int t = threadIdx.x; asm volatile("" : "+v"(t)); return t; }
DI int opaque_bid() { int t = blockIdx.x; asm volatile("" : "+s"(t)); return t; }
DI unsigned pk2(float a, float b) { f32x2 v = {a, b}; bf16x2_t r = __builtin_convertvector(v, bf16x2_t); return __builtin_bit_cast(unsigned, r); }
DI float bf2f(short s) { return __uint_as_float(((unsigned)(unsigned short)s) << 16); }

namespace pg8 {
constexpr int BM = 256, BK = 64, HALF = 128, HTB = HALF * BK * 2, STAGE_BYTES = 8 * HTB, NXCD = 8, WGM = 8;
DI int lds_byte(int r, int c) { const int st = (r >> 4) * 2 + (c >> 5), rr = r & 15, cc = c & 31, ob = rr * 64 + cc * 2; return st * 1024 + (ob ^ (((ob >> 9) & 1) << 5)); }
DI void stage_rc(int b, int& R, int& C) { const int st = b / 1024, sb = b % 1024, swz = sb ^ (((sb >> 9) & 1) << 5); R = (st >> 1) * 16 + swz / 64; C = (st & 1) * 32 + (swz % 64) / 2; }
DI int perm32(int rho) { const int n = rho >> 4, i = rho & 15; return 8 * (i >> 2) + 4 * n + (i & 3); }

struct Unit { int pm, pn; };
struct Gemm { const bf16_t* A; const bf16_t* Bt; int M, N, K; };

struct StaticOrder {
    int nM, nN, nwg, G, c;
    DI void init(int M, int N, int G_, int c_) { nM = M / BM; nN = N / BM; nwg = nM * nN; G = G_; c = c_; }
    DI bool next(int i, Unit& u) const {
        const long L = (long)i * G + c; if (L >= nwg) return false;
        int wgid = (int)L; { const int q = nwg / NXCD, r = nwg % NXCD, xcd = wgid % NXCD, off = wgid / NXCD; wgid = (xcd < r ? xcd * (q + 1) : r * (q + 1) + (xcd - r) * q) + off; }
        const int nig = WGM * nN, gid = wgid / nig, fm = gid * WGM, gsz = (nM - fm) < WGM ? (nM - fm) : WGM;
        u.pm = fm + ((wgid % nig) % gsz); u.pn = (wgid % nig) / gsz; return true;
    }
};


struct EpiZ {
    static constexpr bool PERM = false;
    const float* res; float* out; const float* gate; float w;
    DI void operator()(const f32x4 (&acc)[2][2][4][2], const Unit& u, int wr, int wc, int fr, int fq) const {
        const int row0 = u.pm * BM + wr * 64 + fr, col0 = u.pn * BM + wc * 32 + 4 * fq;
        const float* gp = gate + (size_t)(u.pm >> 3) * 9216 + col0;
        f32x4 cf[2][2];
#pragma unroll
        for (int bj = 0; bj < 2; ++bj)
#pragma unroll
            for (int n = 0; n < 2; ++n) { const f32x4 g = *(const f32x4*)(gp + bj * HALF + n * 16); cf[bj][n] = (g + 1.0f) * w; }
#pragma unroll
        for (int ai = 0; ai < 2; ++ai)
#pragma unroll
            for (int m = 0; m < 4; ++m) { const size_t off = (size_t)(row0 + ai * HALF + m * 16) * DM + col0;
#pragma unroll
                for (int bj = 0; bj < 2; ++bj)
#pragma unroll
                    for (int n = 0; n < 2; ++n) { const f32x4 rs = *(const f32x4*)(res + off + bj * HALF + n * 16);
                        *(f32x4*)(out + off + bj * HALF + n * 16) = rs * DN_ALPHA + cf[bj][n] * acc[ai][bj][m][n]; }
                asm volatile("" ::: "memory"); }
    }
};
struct EpiSwiglu {
    static constexpr bool PERM = true;
    bf16_t* O;
    DI void operator()(const f32x4 (&acc)[2][2][4][2], const Unit& u, int wr, int wc, int fr, int fq) const {
        const int row0 = u.pm * BM + wr * 64 + fr, col0 = u.pn * HALF + wc * 32 + 8 * fq;
#pragma unroll
        for (int ai = 0; ai < 2; ++ai)
#pragma unroll
            for (int m = 0; m < 4; ++m) {
                float a[8];
#pragma unroll
                for (int n = 0; n < 2; ++n)
#pragma unroll
                    for (int j = 0; j < 4; ++j) { const float g = acc[ai][0][m][n][j], uu = acc[ai][1][m][n][j];
                        a[n * 4 + j] = g * __builtin_amdgcn_rcpf(1.0f + __expf(-g)) * uu; }
                u32x4 w; w.x = pk2(a[0], a[1]); w.y = pk2(a[2], a[3]); w.z = pk2(a[4], a[5]); w.w = pk2(a[6], a[7]);
                *(u32x4*)(O + (size_t)(row0 + ai * HALF + m * 16) * DFF + col0) = w; }
    }
};
struct EpiBf16 {
    static constexpr bool PERM = true;
    bf16_t* O; int ldc;
    DI void operator()(const f32x4 (&acc)[2][2][4][2], const Unit& u, int wr, int wc, int fr, int fq) const {
        const int row0 = u.pm * BM + wr * 64 + fr, col0 = u.pn * BM + wc * 32 + 8 * fq;
#pragma unroll
        for (int ai = 0; ai < 2; ++ai)
#pragma unroll
            for (int m = 0; m < 4; ++m) { bf16_t* rowp = O + (size_t)(row0 + ai * HALF + m * 16) * ldc + col0;
#pragma unroll
                for (int bj = 0; bj < 2; ++bj) { const f32x4 v0 = acc[ai][bj][m][0], v1 = acc[ai][bj][m][1];
                    u32x4 w; w.x = pk2(v0[0], v0[1]); w.y = pk2(v0[2], v0[3]); w.z = pk2(v1[0], v1[1]); w.w = pk2(v1[2], v1[3]);
                    *(u32x4*)(rowp + bj * HALF) = w; } }
    }
};
struct EpiQKRot {
    static constexpr bool PERM = true;
    bf16_t* Q; bf16_t* K; const float* rot; float* kpart;
    DI void operator()(const f32x4 (&acc)[2][2][4][2], const Unit& u, int wr, int wc, int fr, int fq) const {
        const int row0 = u.pm * BM + wr * 64 + fr; const int isk = (u.pn >= 4) ? 1 : 0; const int cc = (u.pn - 4 * isk) * BM;
        bf16_t* base = isk ? K : Q; const int col0 = cc + wc * 32 + 8 * fq;
        f32x4 cs[2][2];
#pragma unroll
        for (int bj = 0; bj < 2; ++bj)
#pragma unroll
            for (int n = 0; n < 2; ++n) cs[bj][n] = (f32x4){0.f, 0.f, 0.f, 0.f};
#pragma unroll
        for (int ai = 0; ai < 2; ++ai)
#pragma unroll
            for (int m = 0; m < 4; ++m) { const int row = row0 + ai * HALF + m * 16; const int pos = row & (SEQ - 1);
                f32x4 c0 = {1.f, 1.f, 1.f, 1.f}, c1 = c0, s0 = {0.f, 0.f, 0.f, 0.f}, s1 = s0;
                if (wc == 0) { const float* rp = rot + pos * 16 + 8 * (fq & 1); c0 = *(const f32x4*)rp; c1 = *(const f32x4*)(rp + 4); s0 = *(const f32x4*)(rp + 2048 * 16); s1 = *(const f32x4*)(rp + 2048 * 16 + 4);
                    if (fq < 2) { s0 = -s0; s1 = -s1; } }
#pragma unroll
                for (int bj = 0; bj < 2; ++bj) { f32x4 v0 = acc[ai][bj][m][0], v1 = acc[ai][bj][m][1];
                    if (wc == 0) { f32x4 p0, p1;
#pragma unroll
                        for (int j = 0; j < 4; ++j) { p0[j] = __shfl_xor(v0[j], 32); p1[j] = __shfl_xor(v1[j], 32); }
                        v0 = v0 * c0 + p0 * s0; v1 = v1 * c1 + p1 * s1; }
                    cs[bj][0] += v0; cs[bj][1] += v1;
                    u32x4 w; w.x = pk2(v0[0], v0[1]); w.y = pk2(v0[2], v0[3]); w.z = pk2(v1[0], v1[1]); w.w = pk2(v1[2], v1[3]);
                    *(u32x4*)(base + (size_t)row * DM + col0 + bj * HALF) = w; } }
        if (isk) {
#pragma unroll
            for (int bj = 0; bj < 2; ++bj)
#pragma unroll
                for (int n = 0; n < 2; ++n) { f32x4 v = cs[bj][n];
#pragma unroll
                    for (int j = 0; j < 4; ++j) { float t = v[j]; t += __shfl_xor(t, 1); t += __shfl_xor(t, 2); t += __shfl_xor(t, 4); t += __shfl_xor(t, 8); v[j] = t; }
                    if (fr == 0) *(f32x4*)(kpart + (size_t)(u.pm * 2 + wr) * DM + col0 + bj * HALF + 4 * n) = v; }
        }
    }
};

template <class Epi, class Sched>
DI void gemm_phase(LAS unsigned char* lds, const Gemm g, const Sched& S, const Epi& E) {
    const int tid = opaque_tid(), wid = __builtin_amdgcn_readfirstlane(tid >> 6), lane = tid & 63, wr = wid >> 2, wc = wid & 3, fr = lane & 15, fq = lane >> 4;
    const int K = g.K, nt = K / BK;
    unsigned voffA[2], voffB[2];
#pragma unroll
    for (int i = 0; i < 2; ++i) { int R, C; stage_rc(tid * 16 + i * 8192, R, C); const int Rb = Epi::PERM ? ((R & ~31) + perm32(R & 31)) : R;
        voffA[i] = (unsigned)(R * K + C) * 2u; voffB[i] = (unsigned)(Rb * K + C) * 2u; }
    const size_t kstep = (size_t)(BK * 2);
    const size_t hstep = (size_t)HALF * K * 2;
    const size_t tstep = 2 * hstep;
    const unsigned ldsw = (unsigned)wid * 1024u;
    const int aoff = lds_byte(wr * 64 + fr, fq * 8), boff = lds_byte(wc * 32 + fr, fq * 8);
#define PG8_SA(b, h) (((b) * 2 + (h)) * HTB)
#define PG8_SB(b, h) ((4 + (b) * 2 + (h)) * HTB)
#define PG8_STAGE(bufoff, gbase, voff) do { _Pragma("unroll") for (int _i = 0; _i < 2; ++_i) \
        __builtin_amdgcn_global_load_lds((const unsigned*)((const char*)(gbase) + (voff)[_i]), (LAS unsigned*)(lds + (bufoff) + ldsw + _i * 8192), 16, 0, 0); } while (0)
#define PG8_LDA(dst, b, h) do { _Pragma("unroll") for (int m = 0; m < 4; ++m) _Pragma("unroll") for (int k = 0; k < 2; ++k) dst[m][k] = *(const LAS bf16x8*)(lds + PG8_SA(b, h) + aoff + m * 2048 + k * 1024); } while (0)
#define PG8_LDB(dst, b, h) do { _Pragma("unroll") for (int n = 0; n < 2; ++n) _Pragma("unroll") for (int k = 0; k < 2; ++k) dst[n][k] = *(const LAS bf16x8*)(lds + PG8_SB(b, h) + boff + n * 2048 + k * 1024); } while (0)
#define PG8_MMA(ai, bj, At, Bt) do { __builtin_amdgcn_s_setprio(1); _Pragma("unroll") for (int m = 0; m < 4; ++m) _Pragma("unroll") for (int n = 0; n < 2; ++n) _Pragma("unroll") for (int k = 0; k < 2; ++k) \
        acc[ai][bj][m][n] = __builtin_amdgcn_mfma_f32_16x16x32_bf16(Bt[n][k], At[m][k], acc[ai][bj][m][n], 0, 0, 0); __builtin_amdgcn_s_setprio(0); } while (0)
#define PG8_WAIT_V(n) asm volatile("s_waitcnt vmcnt(" #n ")" ::: "memory")
#define PG8_WAIT_L(n) asm volatile("s_waitcnt lgkmcnt(" #n ")" ::: "memory")
#define PG8_BAR __builtin_amdgcn_s_barrier()
#define PG8_SCHED __builtin_amdgcn_sched_barrier(0)
    Unit cur, nxt; int ui = 0;
    if (!S.next(0, cur)) return;
    f32x4 acc[2][2][4][2];
#pragma unroll
    for (int a = 0; a < 2; ++a)
#pragma unroll
        for (int b = 0; b < 2; ++b)
#pragma unroll
            for (int m = 0; m < 4; ++m)
#pragma unroll
                for (int n = 0; n < 2; ++n) acc[a][b][m][n] = (f32x4){0.f, 0.f, 0.f, 0.f};
    bf16x8 At[4][2], B0[2][2], B1[2][2];
    const char* cA = (const char*)g.A + (size_t)cur.pm * tstep; const char* cB = (const char*)g.Bt + (size_t)cur.pn * tstep;
    PG8_STAGE(PG8_SB(0, 0), cB, voffB); PG8_STAGE(PG8_SA(0, 0), cA, voffA); PG8_STAGE(PG8_SB(0, 1), cB + hstep, voffB); PG8_STAGE(PG8_SA(0, 1), cA + hstep, voffA);
    if (wr == 1) PG8_BAR;
    PG8_WAIT_V(4); PG8_BAR;
    PG8_STAGE(PG8_SB(1, 0), cB + kstep, voffB); PG8_STAGE(PG8_SA(1, 0), cA + kstep, voffA); PG8_STAGE(PG8_SB(1, 1), cB + hstep + kstep, voffB);
    PG8_WAIT_V(6); PG8_BAR;
    for (;;) {
        const bool has_next = S.next(ui + 1, nxt);
        const char* nA = has_next ? (const char*)g.A + (size_t)nxt.pm * tstep : cA; const char* nB = has_next ? (const char*)g.Bt + (size_t)nxt.pn * tstep : cB;
        for (int t = 0; t < nt; t += 2) {
            const bool last = (t == nt - 2);
            const char* a1 = cA + (size_t)(t + 1) * kstep;
            const char* a2 = last ? nA : cA + (size_t)(t + 2) * kstep; const char* b2 = last ? nB : cB + (size_t)(t + 2) * kstep;
            const char* a3 = a2 + kstep; const char* b3 = b2 + kstep;
            PG8_LDB(B0, 0, 0); PG8_SCHED; PG8_LDA(At, 0, 0); PG8_STAGE(PG8_SA(1, 1), a1 + hstep, voffA);
            PG8_WAIT_L(8); PG8_BAR; PG8_WAIT_L(0); PG8_MMA(0, 0, At, B0); PG8_BAR; PG8_SCHED;
            PG8_LDB(B1, 0, 1); PG8_STAGE(PG8_SB(0, 0), b2, voffB);
            PG8_BAR; PG8_WAIT_L(0); PG8_MMA(0, 1, At, B1); PG8_BAR;
            PG8_LDA(At, 0, 1); PG8_STAGE(PG8_SA(0, 0), a2, voffA);
            PG8_BAR; PG8_WAIT_L(0); PG8_MMA(1, 0, At, B0); PG8_BAR; PG8_SCHED;
            PG8_STAGE(PG8_SB(0, 1), b2 + hstep, voffB);
            PG8_WAIT_V(6); PG8_BAR; PG8_MMA(1, 1, At, B1); PG8_BAR;
            PG8_LDB(B0, 1, 0); PG8_SCHED; PG8_LDA(At, 1, 0); PG8_STAGE(PG8_SA(0, 1), a2 + hstep, voffA);
            PG8_WAIT_L(8); PG8_BAR; PG8_WAIT_L(0); PG8_MMA(0, 0, At, B0); PG8_BAR; PG8_SCHED;
            PG8_LDB(B1, 1, 1); PG8_STAGE(PG8_SB(1, 0), b3, voffB);
            PG8_BAR; PG8_WAIT_L(0); PG8_MMA(0, 1, At, B1); PG8_BAR;
            PG8_LDA(At, 1, 1); PG8_STAGE(PG8_SA(1, 0), a3, voffA);
            PG8_BAR; PG8_WAIT_L(0); PG8_MMA(1, 0, At, B0); PG8_BAR; PG8_SCHED;
            PG8_STAGE(PG8_SB(1, 1), b3 + hstep, voffB);
            PG8_WAIT_V(6); PG8_BAR; PG8_MMA(1, 1, At, B1); PG8_BAR;
        }
        E(acc, cur, wr, wc, fr, fq);
        if (!has_next) break;
#pragma unroll
        for (int a = 0; a < 2; ++a)
#pragma unroll
            for (int b = 0; b < 2; ++b)
#pragma unroll
                for (int m = 0; m < 4; ++m)
#pragma unroll
                    for (int n = 0; n < 2; ++n) acc[a][b][m][n] = (f32x4){0.f, 0.f, 0.f, 0.f};
        cur = nxt; cA = nA; cB = nB; ++ui;
    }
    PG8_WAIT_V(0);
    if (wr == 0) PG8_BAR;
    PG8_BAR;
#undef PG8_SA
#undef PG8_SB
#undef PG8_STAGE
#undef PG8_LDA
#undef PG8_LDB
#undef PG8_MMA
#undef PG8_WAIT_V
#undef PG8_WAIT_L
#undef PG8_BAR
#undef PG8_SCHED
}
}

DI int crow(int reg, int h) { return (reg & 3) + 8 * (reg >> 2) + 4 * h; }

DI void transpose_tile(LAS float* tile, const float* __restrict__ src, bf16_t* __restrict__ dst, int K, int N, int mode, int tk, int tn) {
    const int t = opaque_tid(), k0 = tk * 64, n0 = tn * 64;
    { const int r = t >> 4, c4 = (t & 15) * 4;
#pragma unroll
      for (int rr = 0; rr < 2; ++rr) { const f32x4 v = *(const f32x4*)(src + (size_t)(k0 + r + 32 * rr) * N + n0 + c4);
          LAS float* tp = tile + (r + 32 * rr) * 65 + c4; tp[0] = v[0]; tp[1] = v[1]; tp[2] = v[2]; tp[3] = v[3]; } }
    __syncthreads();
    { const int n = t >> 3, k8 = (t & 7) * 8; float a[8];
#pragma unroll
      for (int i = 0; i < 8; ++i) a[i] = tile[(k8 + i) * 65 + n];
      int nn = n0 + n, drow = nn;
      if (mode == 1) { const int up = nn >= DFF ? 1 : 0; const int c = nn - up * DFF; drow = (c >> 7) * 256 + up * 128 + (c & 127); }
      u32x4 w; w.x = pk2(a[0], a[1]); w.y = pk2(a[2], a[3]); w.z = pk2(a[4], a[5]); w.w = pk2(a[6], a[7]);
      *(u32x4*)(dst + (size_t)drow * K + k0 + k8) = w; }
    __syncthreads();
}

DI void sincos_d(float ang, float& cs, float& sn) {
    const double x = (double)ang; const double n = __builtin_rint(x * 0.63661977236758134308); const double y = x - n * 1.57079632679489661923; const double y2 = y * y;
    double s = -1.0 / 39916800.0; s = s * y2 + 1.0 / 362880.0; s = s * y2 - 1.0 / 5040.0; s = s * y2 + 1.0 / 120.0; s = s * y2 - 1.0 / 6.0; s = s * y2 + 1.0; s = s * y;
    double c = 1.0 / 479001600.0; c = c * y2 - 1.0 / 3628800.0; c = c * y2 + 1.0 / 40320.0; c = c * y2 - 1.0 / 720.0; c = c * y2 + 1.0 / 24.0; c = c * y2 - 0.5; c = c * y2 + 1.0;
    const int q = ((int)n) & 3;
    const double cc = (q == 0) ? c : (q == 1) ? -s : (q == 2) ? -c : s;
    const double ss = (q == 0) ? s : (q == 1) ? c : (q == 2) ? -s : -c;
    cs = (float)cc; sn = (float)ss;
}

DI void prep_phase(const Params& p, LAS unsigned char* lds) {
    const int t = opaque_tid(), wave = t >> 6, lane = t & 63, r = lane & 31, hh = lane >> 5; const int bid = opaque_bid();
    float* MOD = (float*)(p.ws + WS_MOD); float* KVMOD = (float*)(p.ws + WS_KVMOD); float* ROT = (float*)(p.ws + WS_ROT);
    const int gw = bid * 8 + wave;
    for (int mt = gw; mt < 640; mt += gridDim.x * 8) {
        const int gc0 = mt * 32; const float* W; int ldw; const float* bias; float* dst; int dstride;
        if (gc0 < 18432) { const int l = gc0 >= 9216 ? 1 : 0; const int j0 = gc0 - l * 9216; W = p.w_ada + (size_t)l * 1024 * 9216 + j0; ldw = 9216; bias = p.b_ada + l * 9216 + j0; dst = MOD + (size_t)l * 32 * 9216 + j0; dstride = 9216; }
        else { const int j0 = gc0 - 18432; W = p.w_kv_ada + j0; ldw = 2048; bias = p.b_kv_ada + j0; dst = KVMOD + j0; dstride = 2048; }
        f32x16 acc;
#pragma unroll
        for (int i = 0; i < 16; ++i) acc[i] = 0.f;
        const float* cp = p.c + r * 1024 + hh; const float* wp = W + (size_t)hh * ldw + r;
#pragma unroll 8
        for (int it = 0; it < 512; ++it) { const float cv = cp[2 * it]; const float a = cv / (1.0f + __expf(-cv)); const float bv = wp[(size_t)(2 * it) * ldw];
            acc = __builtin_amdgcn_mfma_f32_32x32x2f32(a, bv, acc, 0, 0, 0); }
        const float bb = bias[r];
#pragma unroll
        for (int reg = 0; reg < 16; ++reg) dst[(size_t)crow(reg, hh) * dstride + r] = acc[reg] + bb;
    }
    { const int gt = (gridDim.x - 1 - bid) * 512 + t;
      if (gt < 2048 * 16) { const int pos = gt >> 4, i = gt & 15; const float invf = __builtin_amdgcn_exp2f(-(float)i * (18.931568569324174f / 16.0f));
          const float ang = (float)pos * invf; float cs, sn; sincos_d(ang, cs, sn); ROT[gt] = cs; ROT[2048 * 16 + gt] = sn; } }
    LAS float* tile = (LAS float*)lds;
    for (int it = bid; it < 10496; it += gridDim.x) {
        const float* src; bf16_t* dst; int K, N, mode = 0, loc;
        if (it < 5632) { const int j = it / 1408; loc = it - j * 1408; src = p.w_ffn_in + (size_t)j * 1024 * 5632; dst = (bf16_t*)(p.ws + WS_WIN) + (size_t)j * 5632 * 1024; K = 1024; N = 5632; mode = 1; }
        else if (it < 8448) { const int j = (it - 5632) / 704; loc = it - 5632 - j * 704; src = p.w_ffn_out + (size_t)j * 2816 * 1024; dst = (bf16_t*)(p.ws + WS_WOUT) + (size_t)j * 1024 * 2816; K = 2816; N = 1024; }
        else if (it < 9216) { loc = it - 8448; src = p.w_qkv_a; dst = (bf16_t*)(p.ws + WS_WQKV); K = 1024; N = 3072; }
        else if (it < 9472) { loc = it - 9216; src = p.w_q_b; dst = (bf16_t*)(p.ws + WS_WQB); K = 1024; N = 1024; }
        else if (it < 9984) { loc = it - 9472; src = p.w_kv_b; dst = (bf16_t*)(p.ws + WS_WKVB); K = 1024; N = 2048; }
        else { const int j = (it - 9984) / 256; loc = it - 9984 - j * 256; src = p.w_o + (size_t)j * 1024 * 1024; dst = (bf16_t*)(p.ws + WS_WO) + (size_t)j * 1024 * 1024; K = 1024; N = 1024; }
        const int ntn = N / 64; const int tk = loc / ntn, tn = loc - tk * ntn;
        transpose_tile(tile, src, dst, K, N, mode, tk, tn);
    }
}

DI void row_phase(const float* zin, float* xout, const float* lng, const float* lnb, bf16_t* h1, const float* m1, int st1, bf16_t* h2, const float* m2, int st2) {
    const int tid = opaque_tid(); const int wave = tid >> 6, lane = tid & 63;
    const int gw = opaque_bid() * 8 + wave, nw = gridDim.x * 8;
    for (int row = gw; row < T_TOK; row += nw) {
        const int b = row >> 11; f32x4 v[4];
#pragma unroll
        for (int i = 0; i < 4; ++i) v[i] = *(const f32x4*)(zin + (size_t)row * DM + i * 256 + lane * 4);
        if (lng) {
            float s = 0.f;
#pragma unroll
            for (int i = 0; i < 4; ++i) s += (v[i][0] + v[i][1]) + (v[i][2] + v[i][3]);
#pragma unroll
            for (int o = 32; o >= 1; o >>= 1) s += __shfl_xor(s, o);
            const float mean = s * (1.0f / 1024.0f); float q = 0.f;
#pragma unroll
            for (int i = 0; i < 4; ++i) { const f32x4 d = v[i] - mean; q += (d[0] * d[0] + d[1] * d[1]) + (d[2] * d[2] + d[3] * d[3]); }
#pragma unroll
            for (int o = 32; o >= 1; o >>= 1) q += __shfl_xor(q, o);
            const float rstd = 1.0f / sqrtf(q * (1.0f / 1024.0f) + LN_EPS);
#pragma unroll
            for (int i = 0; i < 4; ++i) { const f32x4 g = *(const f32x4*)(lng + i * 256 + lane * 4), bb = *(const f32x4*)(lnb + i * 256 + lane * 4);
                v[i] = (v[i] - mean) * rstd * g + bb; *(f32x4*)(xout + (size_t)row * DM + i * 256 + lane * 4) = v[i]; }
        }
        if (h1) {
            const float* sh = m1 + (size_t)b * st1;
#pragma unroll
            for (int i = 0; i < 4; ++i) { const f32x4 a = *(const f32x4*)(sh + i * 256 + lane * 4), sc = *(const f32x4*)(sh + 1024 + i * 256 + lane * 4);
                const f32x4 h = v[i] * (sc + 1.0f) + a; u32x2 w; w.x = pk2(h[0], h[1]); w.y = pk2(h[2], h[3]); *(u32x2*)(h1 + (size_t)row * DM + i * 256 + lane * 4) = w; }
        }
        if (h2) {
            const float* sh = m2 + (size_t)b * st2;
#pragma unroll
            for (int i = 0; i < 4; ++i) { const f32x4 a = *(const f32x4*)(sh + i * 256 + lane * 4), sc = *(const f32x4*)(sh + 1024 + i * 256 + lane * 4);
                const f32x4 h = v[i] * (sc + 1.0f) + a; u32x2 w; w.x = pk2(h[0], h[1]); w.y = pk2(h[2], h[3]); *(u32x2*)(h2 + (size_t)row * DM + i * 256 + lane * 4) = w; }
        }
    }
}

DI f32x16 mfma32(bf16x8 a, bf16x8 b, f32x16 c) { return __builtin_amdgcn_mfma_f32_32x32x16_bf16(a, b, c, 0, 0, 0); }
DI bf16x8 pack8(const f32x16& x, int s) {
    u32x4 p; p.x = pk2(x[8 * s], x[8 * s + 1]); p.y = pk2(x[8 * s + 2], x[8 * s + 3]); p.z = pk2(x[8 * s + 4], x[8 * s + 5]); p.w = pk2(x[8 * s + 6], x[8 * s + 7]);
    return __builtin_bit_cast(bf16x8, p);
}
DI bf16x8 ldg16(const char* base, unsigned voff) { return *(const bf16x8*)(base + voff); }
DI s16x4 ldg8(const char* base, unsigned voff) { return *(const s16x4*)(base + voff); }
DI void pv_step(f32x16 (&O)[4], const f32x16& pt, const char* vb, unsigned vvoff) {
#pragma unroll
    for (int s = 0; s < 2; ++s) { const bf16x8 pf = pack8(pt, s);
#pragma unroll
        for (int dt = 0; dt < 4; ++dt) { const char* vp = vb + (size_t)(32 * dt) * T_TOK * 2 + 32 * s;
            const s16x4 lo = ldg8(vp, vvoff), hi = ldg8(vp + 16, vvoff);
            const bf16x8 vf = __builtin_shufflevector(lo, hi, 0, 1, 2, 3, 4, 5, 6, 7);
            O[dt] = mfma32(vf, pf, O[dt]); } }
}
DI void store_ot(const f32x16 (&O)[4], float inv, bf16_t* orow, int hh) {
#pragma unroll
    for (int dt = 0; dt < 4; ++dt)
#pragma unroll
        for (int rq = 0; rq < 4; ++rq) { u32x2 w; w.x = pk2(O[dt][4 * rq] * inv, O[dt][4 * rq + 1] * inv); w.y = pk2(O[dt][4 * rq + 2] * inv, O[dt][4 * rq + 3] * inv);
            *(u32x2*)(orow + 32 * dt + 8 * rq + 4 * hh) = w; }
}

DI void moba_phase(const bf16_t* __restrict__ Q, const bf16_t* __restrict__ Kb, const bf16_t* __restrict__ VT, const float* __restrict__ kpart, bf16_t* __restrict__ out) {
    const int tid = opaque_tid(); const int wave = __builtin_amdgcn_readfirstlane(tid >> 6), lane = tid & 63, r = lane & 31, hh = lane >> 5;
    const float c2 = 0.08838834764831845f * 1.4426950408889634f;
    const unsigned kvoff = (unsigned)(r * DM + 8 * hh) * 2u, vvoff = (unsigned)(r * T_TOK + 4 * hh) * 2u;
    for (int bh = opaque_bid(); bh < NB * NH; bh += gridDim.x) {
        const int b = bh >> 3, head = bh & 7;
        const bf16_t* Kh = Kb + (size_t)b * SEQ * DM + head * 128;
        const bf16_t* Vh = VT + (size_t)(head * 128) * T_TOK + (size_t)b * SEQ;
        for (int cur = 0; cur < 8; ++cur) {
            const int g = (wave + cur) & 7; const int qpos = 256 * cur + 32 * g + r;
            const char* qb = (const char*)(Q + ((size_t)b * SEQ + 256 * cur + 32 * g) * DM + head * 128);
            bf16x8 qf[8];
#pragma unroll
            for (int ks = 0; ks < 8; ++ks) qf[ks] = ldg16(qb + 32 * ks, kvoff);
            unsigned selmask = (1u << cur) - 1u;
            if (cur > 3) {
                float v1 = -3.0e38f, v2 = -3.0e38f, v3 = -3.0e38f; int i1 = 0, i2 = 0, i3 = 0;
#pragma unroll 1
                for (int kb = 0; kb < cur; ++kb) {
                    const float* kp = kpart + (size_t)((b * 8 + kb) * 2) * DM + head * 128 + 8 * hh; float acc = 0.f;
#pragma unroll
                    for (int ks = 0; ks < 8; ++ks) { const f32x4 a0 = *(const f32x4*)(kp + 16 * ks), a1 = *(const f32x4*)(kp + 16 * ks + 4), b0 = *(const f32x4*)(kp + DM + 16 * ks), b1 = *(const f32x4*)(kp + DM + 16 * ks + 4);
                        const f32x4 k0 = a0 + b0, k1 = a1 + b1;
#pragma unroll
                        for (int j = 0; j < 4; ++j) { acc += bf2f(qf[ks][j]) * k0[j]; acc += bf2f(qf[ks][4 + j]) * k1[j]; }
                        if (ks & 1) asm volatile("" ::: "memory"); }
                    acc += __shfl_xor(acc, 32);
                    const bool g1 = acc > v1, g2 = acc > v2, g3 = acc > v3;
                    v3 = g2 ? v2 : (g3 ? acc : v3); i3 = g2 ? i2 : (g3 ? kb : i3);
                    v2 = g1 ? v1 : (g2 ? acc : v2); i2 = g1 ? i1 : (g2 ? kb : i2);
                    v1 = g1 ? acc : v1; i1 = g1 ? kb : i1;
                }
                selmask = (1u << i1) | (1u << i2) | (1u << i3);
            }
            float m = -1.0e30f, lsum = 0.f; f32x16 O[4];
#pragma unroll
            for (int dt = 0; dt < 4; ++dt)
#pragma unroll
                for (int i = 0; i < 16; ++i) O[dt][i] = 0.f;
            for (int kb = 0; kb <= cur; ++kb) {
                const bool own = (kb == cur); const bool lsel = own || (((selmask >> kb) & 1u) != 0u);
                if (!own && __ballot(lsel) == 0ull) continue;
                const int ntile = own ? (((32 * g + 31) >> 6) + 1) : 4;
                for (int tile = 0; tile < ntile; ++tile) {
                    const int kbase = 256 * kb + 64 * tile;
                    const char* kp0 = (const char*)(Kh + (size_t)kbase * DM); const char* kp1 = kp0 + 32 * DM * 2;
                    f32x16 s0, s1;
#pragma unroll
                    for (int i = 0; i < 16; ++i) { s0[i] = 0.f; s1[i] = 0.f; }
#pragma unroll
                    for (int ks = 0; ks < 8; ++ks) s0 = mfma32(ldg16(kp0 + 32 * ks, kvoff), qf[ks], s0);
                    asm volatile("" ::: "memory");
#pragma unroll
                    for (int ks = 0; ks < 8; ++ks) s1 = mfma32(ldg16(kp1 + 32 * ks, kvoff), qf[ks], s1);
                    asm volatile("" ::: "memory");
                    float mt = -3.0e30f;
#pragma unroll
                    for (int reg = 0; reg < 16; ++reg) { const int key0 = kbase + crow(reg, hh);
                        const bool v0 = lsel && (key0 <= qpos), v1 = lsel && (key0 + 32 <= qpos);
                        s0[reg] = v0 ? s0[reg] * c2 : -3.0e30f; s1[reg] = v1 ? s1[reg] * c2 : -3.0e30f; mt = fmaxf(mt, fmaxf(s0[reg], s1[reg])); }
                    mt = fmaxf(mt, __shfl_xor(mt, 32));
                    const float mn = fmaxf(m, mt); const float alpha = __builtin_amdgcn_exp2f(m - mn); m = mn;
                    float ps = 0.f;
#pragma unroll
                    for (int reg = 0; reg < 16; ++reg) { s0[reg] = __builtin_amdgcn_exp2f(s0[reg] - mn); s1[reg] = __builtin_amdgcn_exp2f(s1[reg] - mn); ps += s0[reg] + s1[reg]; }
                    lsum = lsum * alpha + ps;
                    if (__ballot(alpha != 1.0f) != 0ull) {
#pragma unroll
                        for (int dt = 0; dt < 4; ++dt) O[dt] = O[dt] * alpha; }
                    const char* vb = (const char*)(Vh + kbase);
                    pv_step(O, s0, vb, vvoff);
                    asm volatile("" ::: "memory");
                    pv_step(O, s1, vb + 64, vvoff);
                    asm volatile("" ::: "memory");
                }
            }
            lsum += __shfl_xor(lsum, 32);
            store_ot(O, 1.0f / lsum, out + ((size_t)b * SEQ + qpos) * DM + head * 128, hh);
        }
    }
}

DI void sb_phase(const bf16_t* __restrict__ Q, const bf16_t* __restrict__ Kb, const bf16_t* __restrict__ VT, bf16_t* __restrict__ out) {
    const int tid = opaque_tid(); const int wave = __builtin_amdgcn_readfirstlane(tid >> 6), lane = tid & 63, r = lane & 31, hh = lane >> 5;
    const float scale = 0.08838834764831845f;
    const unsigned kvoff = (unsigned)(r * DM + 8 * hh) * 2u, vvoff = (unsigned)(r * T_TOK + 4 * hh) * 2u;
    for (int bh = opaque_bid(); bh < NB * NH; bh += gridDim.x) {
        const int b = bh >> 3, head = bh & 7;
        const bf16_t* Kh = Kb + (size_t)b * SEQ * DM + head * 128;
        const bf16_t* Vh = VT + (size_t)(head * 128) * T_TOK + (size_t)b * SEQ;
        for (int i8 = 0; i8 < 8; ++i8) {
            const int t0 = 32 * (wave + 8 * i8); const int qpos = t0 + r;
            const char* qb = (const char*)(Q + ((size_t)b * SEQ + t0) * DM + head * 128);
            bf16x8 qf[8];
#pragma unroll
            for (int ks = 0; ks < 8; ++ks) qf[ks] = ldg16(qb + 32 * ks, kvoff);
            float R = 0.f; f32x16 O[4];
#pragma unroll
            for (int dt = 0; dt < 4; ++dt)
#pragma unroll
                for (int i = 0; i < 16; ++i) O[dt][i] = 0.f;
            for (int kbase = t0; kbase >= 0; kbase -= 32) {
                f32x16 s;
#pragma unroll
                for (int i = 0; i < 16; ++i) s[i] = 0.f;
                const char* kp0 = (const char*)(Kh + (size_t)kbase * DM);
#pragma unroll
                for (int ks = 0; ks < 8; ++ks) s = mfma32(ldg16(kp0 + 32 * ks, kvoff), qf[ks], s);
                float L[16];
#pragma unroll
                for (int reg = 0; reg < 16; ++reg) { const int key = kbase + crow(reg, hh); const bool valid = key < qpos; const float z = s[reg] * scale;
                    const float sp = fmaxf(z, 0.f) + __logf(1.0f + __expf(-fabsf(z)));
                    L[reg] = valid ? sp : 0.f; s[reg] = valid ? z : -1.0e30f; }
                float Gt[4], Go[4];
#pragma unroll
                for (int g4 = 0; g4 < 4; ++g4) { L[4 * g4 + 2] += L[4 * g4 + 3]; L[4 * g4 + 1] += L[4 * g4 + 2]; L[4 * g4] += L[4 * g4 + 1]; Gt[g4] = L[4 * g4]; }
#pragma unroll
                for (int g4 = 0; g4 < 4; ++g4) Go[g4] = __shfl_xor(Gt[g4], 32);
                float run = R;
#pragma unroll
                for (int g4 = 3; g4 >= 0; --g4) { const float after = run + (hh == 0 ? Go[g4] : 0.f);
#pragma unroll
                    for (int i = 0; i < 4; ++i) s[4 * g4 + i] = __expf(s[4 * g4 + i] - (after + L[4 * g4 + i]));
                    run += Gt[g4] + Go[g4]; }
                R = run;
                pv_step(O, s, (const char*)(Vh + kbase), vvoff);
                if (__ballot(R <= 104.0f) == 0ull) break;
            }
            store_ot(O, 1.0f, out + ((size_t)b * SEQ + qpos) * DM + head * 128, hh);
        }
    }
}

enum { PH_PREP = 0, PH_ROW, PH_SWIGLU, PH_Z, PH_QKROT, PH_BF16, PH_MOBA, PH_SB };
constexpr int NPH = 25;

__global__ void __launch_bounds__(512) fwd_megakernel(Params p) {
    extern __shared__ __attribute__((aligned(16))) unsigned char smem[];
    LAS unsigned char* lds = (LAS unsigned char*)smem;
    cg::grid_group grid = cg::this_grid();
    unsigned char* ws = p.ws;
    bf16_t* HB = (bf16_t*)(ws + WS_HB); bf16_t* QB = (bf16_t*)(ws + WS_QB); bf16_t* KB = (bf16_t*)(ws + WS_KB); bf16_t* VT = (bf16_t*)(ws + WS_VT); bf16_t* ACT = (bf16_t*)(ws + WS_ACT);
    const bf16_t* WIN = (const bf16_t*)(ws + WS_WIN); const bf16_t* WOUT = (const bf16_t*)(ws + WS_WOUT); const bf16_t* WQKV = (const bf16_t*)(ws + WS_WQKV);
    const bf16_t* WQB = (const bf16_t*)(ws + WS_WQB); const bf16_t* WKVB = (const bf16_t*)(ws + WS_WKVB); const bf16_t* WO = (const bf16_t*)(ws + WS_WO);
    const float* MOD = (const float*)(ws + WS_MOD); const float* KVMOD = (const float*)(ws + WS_KVMOD); const float* ROT = (const float*)(ws + WS_ROT); float* KPART = (float*)(ws + WS_KPART);
    float* X = p.out;

    for (int ph = 0; ph < NPH; ++ph) {
        int type = PH_PREP, sync = 1;
        const bf16_t* gA = nullptr; const bf16_t* gB = nullptr; int gM = T_TOK, gN = 0, gK = DM; bf16_t* gO = nullptr; int gld = DM;
        const float* zres = X; const float* zgate = nullptr; float zw = 0.5f;
        const float* rin = X; float* rout = X; const float* rg = nullptr; const float* rb = nullptr; bf16_t* rh1 = nullptr; const float* rm1 = nullptr; int rs1 = 9216; bf16_t* rh2 = nullptr; const float* rm2 = nullptr; int rs2 = 2048;
        const int l = ph >= 13 ? 1 : 0;
        const float* modl = MOD + (size_t)l * 32 * 9216;
        switch (ph) {
            case 0: type = PH_PREP; break;
            case 1: type = PH_ROW; rin = p.x; rh1 = HB; rm1 = MOD; break;
            case 2: case 10: case 15: case 22: { type = PH_SWIGLU; const int s = (ph == 2 || ph == 15) ? 0 : 1; gA = HB; gB = WIN + (size_t)(l * 2 + s) * 5632 * 1024; gN = 5632; gK = DM; gO = ACT; } break;
            case 3: case 11: case 16: case 23: { type = PH_Z; const int s = (ph == 3 || ph == 16) ? 0 : 1; gA = ACT; gB = WOUT + (size_t)(l * 2 + s) * 1024 * 2816; gN = DM; gK = DFF; zres = (ph == 3) ? p.x : X; zgate = modl + (s ? 8 : 2) * 1024; zw = 0.5f; } break;
            case 4: case 17: type = PH_ROW; rg = p.ln_g + (l * 3 + 0) * 1024; rb = p.ln_b + (l * 3 + 0) * 1024; rh1 = HB; rm1 = modl + 3 * 1024; break;
            case 5: type = PH_QKROT; gA = HB; gB = WQKV; gN = 2048; sync = 0; break;
            case 6: type = PH_BF16; gA = WQKV + (size_t)2048 * 1024; gB = HB; gM = DM; gN = T_TOK; gO = VT; gld = T_TOK; break;
            case 7: type = PH_MOBA; break;
            case 8: case 20: type = PH_Z; gA = HB; gB = WO + (size_t)l * 1024 * 1024; gN = DM; gK = DM; zgate = modl + 5 * 1024; zw = 1.0f; break;
            case 9: case 21: type = PH_ROW; rg = p.ln_g + (l * 3 + 1) * 1024; rb = p.ln_b + (l * 3 + 1) * 1024; rh1 = HB; rm1 = modl + 6 * 1024; break;
            case 12: type = PH_ROW; rg = p.ln_g + 2 * 1024; rb = p.ln_b + 2 * 1024; rh1 = HB; rm1 = MOD + (size_t)32 * 9216; rh2 = QB; rm2 = KVMOD; break;
            case 13: type = PH_BF16; gA = QB; gB = WKVB; gN = DM; gO = KB; gld = DM; sync = 0; break;
            case 14: type = PH_BF16; gA = WKVB + (size_t)1024 * 1024; gB = QB; gM = DM; gN = T_TOK; gO = VT; gld = T_TOK; sync = 0; break;
            case 18: type = PH_BF16; gA = HB; gB = WQB; gN = DM; gO = QB; gld = DM; break;
            case 19: type = PH_SB; break;
            case 24: type = PH_ROW; rg = p.ln_g + 5 * 1024; rb = p.ln_b + 5 * 1024; break;
            default: break;
        }
        pg8::Gemm gm; gm.A = gA; gm.Bt = gB; gm.M = gM; gm.N = gN; gm.K = gK;
        pg8::StaticOrder so; so.init(gM, gN > 0 ? gN : 256, gridDim.x, opaque_bid());
        if (type == PH_PREP) prep_phase(p, lds);
        else if (type == PH_ROW) row_phase(rin, rout, rg, rb, rh1, rm1, rs1, rh2, rm2, rs2);
        else if (type == PH_SWIGLU) { pg8::EpiSwiglu e; e.O = gO; pg8::gemm_phase(lds, gm, so, e); }
        else if (type == PH_Z) { pg8::EpiZ e; e.res = zres; e.out = X; e.gate = zgate; e.w = zw; pg8::gemm_phase(lds, gm, so, e); }
        else if (type == PH_QKROT) { pg8::EpiQKRot e; e.Q = QB; e.K = KB; e.rot = ROT; e.kpart = KPART; pg8::gemm_phase(lds, gm, so, e); }
        else if (type == PH_BF16) { pg8::EpiBf16 e; e.O = gO; e.ldc = gld; pg8::gemm_phase(lds, gm, so, e); }
        else if (type == PH_MOBA) moba_phase(QB, KB, VT, KPART, HB);
        else if (type == PH_SB) sb_phase(QB, KB, VT, HB);
        if (sync) grid.sync();
    }
}

constexpr int LDS_BYTES = pg8::STAGE_BYTES;

extern "C" void kernel_launch(void* const* d_in, const int* in_sizes, int n_in, void* d_out, int out_size, void* d_ws, size_t ws_size, hipStream_t stream) {
    static int grid_blocks = 0;
    if (grid_blocks == 0) {
        if (n_in != 14 || out_size != T_TOK * DM || ws_size < WS_END) { fprintf(stderr, "kernel_launch: unexpected shapes (n_in %d out %d ws %zu need %zu)\n", n_in, out_size, ws_size, (size_t)WS_END); grid_blocks = -1; return; }
        int dev = 0, cus = 0, per_cu = 0;
        hipGetDevice(&dev);
        hipDeviceGetAttribute(&cus, hipDeviceAttributeMultiprocessorCount, dev);
        if (hipFuncSetAttribute((const void*)fwd_megakernel, hipFuncAttributeMaxDynamicSharedMemorySize, LDS_BYTES) != hipSuccess) { fprintf(stderr, "kernel_launch: hipFuncSetAttribute failed\n"); grid_blocks = -1; return; }
        hipOccupancyMaxActiveBlocksPerMultiprocessor(&per_cu, (const void*)fwd_megakernel, 512, LDS_BYTES);
        if (per_cu < 1) { fprintf(stderr, "kernel_launch: occupancy query says %d blocks/CU\n", per_cu); per_cu = 1; }
        (void)hipGetLastError();
        grid_blocks = cus;
    }
    if (grid_blocks < 0) return;
    Params p{};
    p.x = (const float*)d_in[0]; p.c = (const float*)d_in[1]; p.w_ada = (const float*)d_in[2]; p.b_ada = (const float*)d_in[3]; p.ln_g = (const float*)d_in[4]; p.ln_b = (const float*)d_in[5];
    p.w_ffn_in = (const float*)d_in[6]; p.w_ffn_out = (const float*)d_in[7]; p.w_qkv_a = (const float*)d_in[8]; p.w_q_b = (const float*)d_in[9]; p.w_kv_ada = (const float*)d_in[10]; p.b_kv_ada = (const float*)d_in[11];
    p.w_kv_b = (const float*)d_in[12]; p.w_o = (const float*)d_in[13]; p.out = (float*)d_out; p.ws = (unsigned char*)d_ws;
    void* args[] = {&p};
    hipError_t e = hipLaunchCooperativeKernel((const void*)fwd_megakernel, dim3(grid_blocks), dim3(512), args, LDS_BYTES, stream);
    if (e != hipSuccess) fprintf(stderr, "cooperative launch failed: %s (grid %d)\n", hipGetErrorString(e), grid_blocks);
}
```

```cpp
#include <hip/hip_runtime.h>
#include <hip/hip_cooperative_groups.h>
#include <cstdio>
namespace cg = cooperative_groups;

#define LAS __attribute__((address_space(3)))
#define DI __device__ __forceinline__
typedef unsigned short bf16_t;
typedef short bf16x8 __attribute__((ext_vector_type(8)));
typedef short s16x4 __attribute__((ext_vector_type(4)));
typedef float f32x4 __attribute__((ext_vector_type(4)));
typedef float f32x2 __attribute__((ext_vector_type(2)));
typedef float f32x16 __attribute__((ext_vector_type(16)));
typedef unsigned u32x4 __attribute__((ext_vector_type(4)));
typedef unsigned u32x2 __attribute__((ext_vector_type(2)));
typedef __bf16 bf16x2_t __attribute__((ext_vector_type(2)));

constexpr int T_TOK = 65536, DM = 1024, DFF = 2816, SEQ = 2048, NB = 32, NH = 8;
constexpr float DN_ALPHA = 1.4142135623730951f;
constexpr float LN_EPS = 1e-5f;

constexpr size_t WS_WIN   = 0;
constexpr size_t WS_WOUT  = WS_WIN  + 4ull * 5632 * 1024 * 2;
constexpr size_t WS_WQKV  = WS_WOUT + 4ull * 1024 * 2816 * 2;
constexpr size_t WS_WQB   = WS_WQKV + 3072ull * 1024 * 2;
constexpr size_t WS_WKVB  = WS_WQB  + 1024ull * 1024 * 2;
constexpr size_t WS_WO    = WS_WKVB + 2048ull * 1024 * 2;
constexpr size_t WS_MOD   = WS_WO   + 2ull * 1024 * 1024 * 2;
constexpr size_t WS_KVMOD = WS_MOD  + 2ull * 32 * 9216 * 4;
constexpr size_t WS_ROT   = WS_KVMOD + 32ull * 2048 * 4;
constexpr size_t WS_KPART = WS_ROT  + 2ull * 2048 * 16 * 4;
constexpr size_t WS_HB    = WS_KPART + 256ull * 2 * 1024 * 4;
constexpr size_t WS_QB    = WS_HB   + (size_t)T_TOK * DM * 2;
constexpr size_t WS_KB    = WS_QB   + (size_t)T_TOK * DM * 2;
constexpr size_t WS_VT    = WS_KB   + (size_t)T_TOK * DM * 2;
constexpr size_t WS_ACT   = WS_VT   + (size_t)T_TOK * DM * 2;
constexpr size_t WS_END   = WS_ACT  + (size_t)T_TOK * DFF * 2;

struct Params {
    const float* x; const float* c; const float* w_ada; const float* b_ada; const float* ln_g; const float* ln_b;
    const float* w_ffn_in; const float* w_ffn_out; const float* w_qkv_a; const float* w_q_b; const float* w_kv_ada; const float* b_kv_ada;
    const float* w_kv_b; const float* w_o; float* out; unsigned char* ws;
};

DI int opaque_tid() { int t = threadIdx.x; asm volatile("" : "+v"(t)); return t; }
DI int opaque_bid() { int t = blockIdx.x; asm volatile("" : "+s"(t)); return t; }
DI unsigned pk2(float a, float b) { f32x2 v = {a, b}; bf16x2_t r = __builtin_convertvector(v, bf16x2_t); return __builtin_bit_cast(unsigned, r); }
DI float bf2f(short s) { return __uint_as_float(((unsigned)(unsigned short)s) << 16); }

namespace pg8 {
constexpr int BM = 256, BK = 64, HALF = 128, HTB = HALF * BK * 2, STAGE_BYTES = 8 * HTB, NXCD = 8, WGM = 8;
DI int lds_byte(int r, int c) { const int st = (r >> 4) * 2 + (c >> 5), rr = r & 15, cc = c & 31, ob = rr * 64 + cc * 2; return st * 1024 + (ob ^ (((ob >> 9) & 1) << 5)); }
DI void stage_rc(int b, int& R, int& C) { const int st = b / 1024, sb = b % 1024, swz = sb ^ (((sb >> 9) & 1) << 5); R = (st >> 1) * 16 + swz / 64; C = (st & 1) * 32 + (swz % 64) / 2; }
DI int perm32(int rho) { const int n = rho >> 4, i = rho & 15; return 8 * (i >> 2) + 4 * n + (i & 3); }

struct Unit { int pm, pn; };
struct Gemm { const bf16_t* A; const bf16_t* Bt; int M, N, K; };

struct StaticOrder {
    int nM, nN, nwg, G, c;
    DI void init(int M, int N, int G_, int c_) { nM = M / BM; nN = N / BM; nwg = nM * nN; G = G_; c = c_; }
    DI bool next(int i, Unit& u) const {
        const long L = (long)i * G + c; if (L >= nwg) return false;
        int wgid = (int)L; { const int q = nwg / NXCD, r = nwg % NXCD, xcd = wgid % NXCD, off = wgid / NXCD; wgid = (xcd < r ? xcd * (q + 1) : r * (q + 1) + (xcd - r) * q) + off; }
        const int nig = WGM * nN, gid = wgid / nig, fm = gid * WGM, gsz = (nM - fm) < WGM ? (nM - fm) : WGM;
        u.pm = fm + ((wgid % nig) % gsz); u.pn = (wgid % nig) / gsz; return true;
    }
};


struct EpiZ {
    static constexpr bool PERM = false;
    const float* res; float* out; const float* gate; float w;
    DI void operator()(const f32x4 (&acc)[2][2][4][2], const Unit& u, int wr, int wc, int fr, int fq) const {
        const int row0 = u.pm * BM + wr * 64 + fr, col0 = u.pn * BM + wc * 32 + 4 * fq;
        const float* gp = gate + (size_t)(u.pm >> 3) * 9216 + col0;
        f32x4 cf[2][2];
#pragma unroll
        for (int bj = 0; bj < 2; ++bj)
#pragma unroll
            for (int n = 0; n < 2; ++n) { const f32x4 g = *(const f32x4*)(gp + bj * HALF + n * 16); cf[bj][n] = (g + 1.0f) * w; }
#pragma unroll
        for (int ai = 0; ai < 2; ++ai)
#pragma unroll
            for (int m = 0; m < 4; ++m) { const size_t off = (size_t)(row0 + ai * HALF + m * 16) * DM + col0;
#pragma unroll
                for (int bj = 0; bj < 2; ++bj)
#pragma unroll
                    for (int n = 0; n < 2; ++n) { const f32x4 rs = *(const f32x4*)(res + off + bj * HALF + n * 16);
                        *(f32x4*)(out + off + bj * HALF + n * 16) = rs * DN_ALPHA + cf[bj][n] * acc[ai][bj][m][n]; }
                asm volatile("" ::: "memory"); }
    }
};
struct EpiSwiglu {
    static constexpr bool PERM = true;
    bf16_t* O;
    DI void operator()(const f32x4 (&acc)[2][2][4][2], const Unit& u, int wr, int wc, int fr, int fq) const {
        const int row0 = u.pm * BM + wr * 64 + fr, col0 = u.pn * HALF + wc * 32 + 8 * fq;
#pragma unroll
        for (int ai = 0; ai < 2; ++ai)
#pragma unroll
            for (int m = 0; m < 4; ++m) {
                float a[8];
#pragma unroll
                for (int n = 0; n < 2; ++n)
#pragma unroll
                    for (int j = 0; j < 4; ++j) { const float g = acc[ai][0][m][n][j], uu = acc[ai][1][m][n][j];
                        a[n * 4 + j] = g * __builtin_amdgcn_rcpf(1.0f + __expf(-g)) * uu; }
                u32x4 w; w.x = pk2(a[0], a[1]); w.y = pk2(a[2], a[3]); w.z = pk2(a[4], a[5]); w.w = pk2(a[6], a[7]);
                *(u32x4*)(O + (size_t)(row0 + ai * HALF + m * 16) * DFF + col0) = w; }
    }
};
struct EpiBf16 {
    static constexpr bool PERM = true;
    bf16_t* O; int ldc;
    DI void operator()(const f32x4 (&acc)[2][2][4][2], const Unit& u, int wr, int wc, int fr, int fq) const {
        const int row0 = u.pm * BM + wr * 64 + fr, col0 = u.pn * BM + wc * 32 + 8 * fq;
#pragma unroll
        for (int ai = 0; ai < 2; ++ai)
#pragma unroll
            for (int m = 0; m < 4; ++m) { bf16_t* rowp = O + (size_t)(row0 + ai * HALF + m * 16) * ldc + col0;
#pragma unroll
                for (int bj = 0; bj < 2; ++bj) { const f32x4 v0 = acc[ai][bj][m][0], v1 = acc[ai][bj][m][1];
                    u32x4 w; w.x = pk2(v0[0], v0[1]); w.y = pk2(v0[2], v0[3]); w.z = pk2(v1[0], v1[1]); w.w = pk2(v1[2], v1[3]);
                    *(u32x4*)(rowp + bj * HALF) = w; } }
    }
};
struct EpiQKRot {
    static constexpr bool PERM = true;
    bf16_t* Q; bf16_t* K; const float* rot; float* kpart;
    DI void operator()(const f32x4 (&acc)[2][2][4][2], const Unit& u, int wr, int wc, int fr, int fq) const {
        const int row0 = u.pm * BM + wr * 64 + fr; const int isk = (u.pn >= 4) ? 1 : 0; const int cc = (u.pn - 4 * isk) * BM;
        bf16_t* base = isk ? K : Q; const int col0 = cc + wc * 32 + 8 * fq;
        f32x4 cs[2][2];
#pragma unroll
        for (int bj = 0; bj < 2; ++bj)
#pragma unroll
            for (int n = 0; n < 2; ++n) cs[bj][n] = (f32x4){0.f, 0.f, 0.f, 0.f};
#pragma unroll
        for (int ai = 0; ai < 2; ++ai)
#pragma unroll
            for (int m = 0; m < 4; ++m) { const int row = row0 + ai * HALF + m * 16; const int pos = row & (SEQ - 1);
                f32x4 c0 = {1.f, 1.f, 1.f, 1.f}, c1 = c0, s0 = {0.f, 0.f, 0.f, 0.f}, s1 = s0;
                if (wc == 0) { const float* rp = rot + pos * 16 + 8 * (fq & 1); c0 = *(const f32x4*)rp; c1 = *(const f32x4*)(rp + 4); s0 = *(const f32x4*)(rp + 2048 * 16); s1 = *(const f32x4*)(rp + 2048 * 16 + 4);
                    if (fq < 2) { s0 = -s0; s1 = -s1; } }
#pragma unroll
                for (int bj = 0; bj < 2; ++bj) { f32x4 v0 = acc[ai][bj][m][0], v1 = acc[ai][bj][m][1];
                    if (wc == 0) { f32x4 p0, p1;
#pragma unroll
                        for (int j = 0; j < 4; ++j) { p0[j] = __shfl_xor(v0[j], 32); p1[j] = __shfl_xor(v1[j], 32); }
                        v0 = v0 * c0 + p0 * s0; v1 = v1 * c1 + p1 * s1; }
                    cs[bj][0] += v0; cs[bj][1] += v1;
                    u32x4 w; w.x = pk2(v0[0], v0[1]); w.y = pk2(v0[2], v0[3]); w.z = pk2(v1[0], v1[1]); w.w = pk2(v1[2], v1[3]);
                    *(u32x4*)(base + (size_t)row * DM + col0 + bj * HALF) = w; } }
        if (isk) {
#pragma unroll
            for (int bj = 0; bj < 2; ++bj)
#pragma unroll
                for (int n = 0; n < 2; ++n) { f32x4 v = cs[bj][n];
#pragma unroll
                    for (int j = 0; j < 4; ++j) { float t = v[j]; t += __shfl_xor(t, 1); t += __shfl_xor(t, 2); t += __shfl_xor(t, 4); t += __shfl_xor(t, 8); v[j] = t; }
                    if (fr == 0) *(f32x4*)(kpart + (size_t)(u.pm * 2 + wr) * DM + col0 + bj * HALF + 4 * n) = v; }
        }
    }
};

template <class Epi, class Sched>
DI void gemm_phase(LAS unsigned char* lds, const Gemm g, const Sched& S, const Epi& E) {
    const int tid = opaque_tid(), wid = __builtin_amdgcn_readfirstlane(tid >> 6), lane = tid & 63, wr = wid >> 2, wc = wid & 3, fr = lane & 15, fq = lane >> 4;
    const int K = g.K, nt = K / BK;
    unsigned voffA[2], voffB[2];
#pragma unroll
    for (int i = 0; i < 2; ++i) { int R, C; stage_rc(tid * 16 + i * 8192, R, C); const int Rb = Epi::PERM ? ((R & ~31) + perm32(R & 31)) : R;
        voffA[i] = (unsigned)(R * K + C) * 2u; voffB[i] = (unsigned)(Rb * K + C) * 2u; }
    const size_t kstep = (size_t)(BK * 2);
    const size_t hstep = (size_t)HALF * K * 2;
    const size_t tstep = 2 * hstep;
    const unsigned ldsw = (unsigned)wid * 1024u;
    const int aoff = lds_byte(wr * 64 + fr, fq * 8), boff = lds_byte(wc * 32 + fr, fq * 8);
#define PG8_SA(b, h) (((b) * 2 + (h)) * HTB)
#define PG8_SB(b, h) ((4 + (b) * 2 + (h)) * HTB)
#define PG8_STAGE(bufoff, gbase, voff) do { _Pragma("unroll") for (int _i = 0; _i < 2; ++_i) \
        __builtin_amdgcn_global_load_lds((const unsigned*)((const char*)(gbase) + (voff)[_i]), (LAS unsigned*)(lds + (bufoff) + ldsw + _i * 8192), 16, 0, 0); } while (0)
#define PG8_LDA(dst, b, h) do { _Pragma("unroll") for (int m = 0; m < 4; ++m) _Pragma("unroll") for (int k = 0; k < 2; ++k) dst[m][k] = *(const LAS bf16x8*)(lds + PG8_SA(b, h) + aoff + m * 2048 + k * 1024); } while (0)
#define PG8_LDB(dst, b, h) do { _Pragma("unroll") for (int n = 0; n < 2; ++n) _Pragma("unroll") for (int k = 0; k < 2; ++k) dst[n][k] = *(const LAS bf16x8*)(lds + PG8_SB(b, h) + boff + n * 2048 + k * 1024); } while (0)
#define PG8_MMA(ai, bj, At, Bt) do { __builtin_amdgcn_s_setprio(1); _Pragma("unroll") for (int m = 0; m < 4; ++m) _Pragma("unroll") for (int n = 0; n < 2; ++n) _Pragma("unroll") for (int k = 0; k < 2; ++k) \
        acc[ai][bj][m][n] = __builtin_amdgcn_mfma_f32_16x16x32_bf16(Bt[n][k], At[m][k], acc[ai][bj][m][n], 0, 0, 0); __builtin_amdgcn_s_setprio(0); } while (0)
#define PG8_WAIT_V(n) asm volatile("s_waitcnt vmcnt(" #n ")" ::: "memory")
#define PG8_WAIT_L(n) asm volatile("s_waitcnt lgkmcnt(" #n ")" ::: "memory")
#define PG8_BAR __builtin_amdgcn_s_barrier()
#define PG8_SCHED __builtin_amdgcn_sched_barrier(0)
    Unit cur, nxt; int ui = 0;
    if (!S.next(0, cur)) return;
    f32x4 acc[2][2][4][2];
#pragma unroll
    for (int a = 0; a < 2; ++a)
#pragma unroll
        for (int b = 0; b < 2; ++b)
#pragma unroll
            for (int m = 0; m < 4; ++m)
#pragma unroll
                for (int n = 0; n < 2; ++n) acc[a][b][m][n] = (f32x4){0.f, 0.f, 0.f, 0.f};
    bf16x8 At[4][2], B0[2][2], B1[2][2];
    const char* cA = (const char*)g.A + (size_t)cur.pm * tstep; const char* cB = (const char*)g.Bt + (size_t)cur.pn * tstep;
    PG8_STAGE(PG8_SB(0, 0), cB, voffB); PG8_STAGE(PG8_SA(0, 0), cA, voffA); PG8_STAGE(PG8_SB(0, 1), cB + hstep, voffB); PG8_STAGE(PG8_SA(0, 1), cA + hstep, voffA);
    if (wr == 1) PG8_BAR;
    PG8_WAIT_V(4); PG8_BAR;
    PG8_STAGE(PG8_SB(1, 0), cB + kstep, voffB); PG8_STAGE(PG8_SA(1, 0), cA + kstep, voffA); PG8_STAGE(PG8_SB(1, 1), cB + hstep + kstep, voffB);
    PG8_WAIT_V(6); PG8_BAR;
    for (;;) {
        const bool has_next = S.next(ui + 1, nxt);
        const char* nA = has_next ? (const char*)g.A + (size_t)nxt.pm * tstep : cA; const char* nB = has_next ? (const char*)g.Bt + (size_t)nxt.pn * tstep : cB;
        for (int t = 0; t < nt; t += 2) {
            const bool last = (t == nt - 2);
            const char* a1 = cA + (size_t)(t + 1) * kstep;
            const char* a2 = last ? nA : cA + (size_t)(t + 2) * kstep; const char* b2 = last ? nB : cB + (size_t)(t + 2) * kstep;
            const char* a3 = a2 + kstep; const char* b3 = b2 + kstep;
            PG8_LDB(B0, 0, 0); PG8_SCHED; PG8_LDA(At, 0, 0); PG8_STAGE(PG8_SA(1, 1), a1 + hstep, voffA);
            PG8_WAIT_L(8); PG8_BAR; PG8_WAIT_L(0); PG8_MMA(0, 0, At, B0); PG8_BAR; PG8_SCHED;
            PG8_LDB(B1, 0, 1); PG8_STAGE(PG8_SB(0, 0), b2, voffB);
            PG8_BAR; PG8_WAIT_L(0); PG8_MMA(0, 1, At, B1); PG8_BAR;
            PG8_LDA(At, 0, 1); PG8_STAGE(PG8_SA(0, 0), a2, voffA);
            PG8_BAR; PG8_WAIT_L(0); PG8_MMA(1, 0, At, B0); PG8_BAR; PG8_SCHED;
            PG8_STAGE(PG8_SB(0, 1), b2 + hstep, voffB);
            PG8_WAIT_V(6); PG8_BAR; PG8_MMA(1, 1, At, B1); PG8_BAR;
            PG8_LDB(B0, 1, 0); PG8_SCHED; PG8_LDA(At, 1, 0); PG8_STAGE(PG8_SA(0, 1), a2 + hstep, voffA);
            PG8_WAIT_L(8); PG8_BAR; PG8_WAIT_L(0); PG8_MMA(0, 0, At, B0); PG8_BAR; PG8_SCHED;
            PG8_LDB(B1, 1, 1); PG8_STAGE(PG8_SB(1, 0), b3, voffB);
            PG8_BAR; PG8_WAIT_L(0); PG8_MMA(0, 1, At, B1); PG8_BAR;
            PG8_LDA(At, 1, 1); PG8_STAGE(PG8_SA(1, 0), a3, voffA);
            PG8_BAR; PG8_WAIT_L(0); PG8_MMA(1, 0, At, B0); PG8_BAR; PG8_SCHED;
            PG8_STAGE(PG8_SB(1, 1), b3 + hstep, voffB);
            PG8_WAIT_V(6); PG8_BAR; PG8_MMA(1, 1, At, B1); PG8_BAR;
        }
        E(acc, cur, wr, wc, fr, fq);
        if (!has_next) break;
#pragma unroll
        for (int a = 0; a < 2; ++a)
#pragma unroll
            for (int b = 0; b < 2; ++b)
#pragma unroll
                for (int m = 0; m < 4; ++m)
#pragma unroll
                    for (int n = 0; n < 2; ++n) acc[a][b][m][n] = (f32x4){0.f, 0.f, 0.f, 0.f};
        cur = nxt; cA = nA; cB = nB; ++ui;
    }
    PG8_WAIT_V(0);
    if (wr == 0) PG8_BAR;
    PG8_BAR;
#undef PG8_SA
#undef PG8_SB
#undef PG8_STAGE
#undef PG8_LDA
#undef PG8_LDB
#undef PG8_MMA
#undef PG8_WAIT_V
#undef PG8_WAIT_L
#undef PG8_BAR
#undef PG8_SCHED
}
}

DI int crow(int reg, int h) { return (reg & 3) + 8 * (reg >> 2) + 4 * h; }

DI void transpose_tile(LAS float* tile, const float* __restrict__ src, bf16_t* __restrict__ dst, int K, int N, int mode, int tk, int tn) {
    const int t = opaque_tid(), k0 = tk * 64, n0 = tn * 64;
    { const int r = t >> 4, c4 = (t & 15) * 4;
#pragma unroll
      for (int rr = 0; rr < 2; ++rr) { const f32x4 v = *(const f32x4*)(src + (size_t)(k0 + r + 32 * rr) * N + n0 + c4);
          LAS float* tp = tile + (r + 32 * rr) * 65 + c4; tp[0] = v[0]; tp[1] = v[1]; tp[2] = v[2]; tp[3] = v[3]; } }
    __syncthreads();
    { const int n = t >> 3, k8 = (t & 7) * 8; float a[8];
#pragma unroll
      for (int i = 0; i < 8; ++i) a[i] = tile[(k8 + i) * 65 + n];
      int nn = n0 + n, drow = nn;
      if (mode == 1) { const int up = nn >= DFF ? 1 : 0; const int c = nn - up * DFF; drow = (c >> 7) * 256 + up * 128 + (c & 127); }
      u32x4 w; w.x = pk2(a[0], a[1]); w.y = pk2(a[2], a[3]); w.z = pk2(a[4], a[5]); w.w = pk2(a[6], a[7]);
      *(u32x4*)(dst + (size_t)drow * K + k0 + k8) = w; }
    __syncthreads();
}

DI void sincos_d(float ang, float& cs, float& sn) {
    const double x = (double)ang; const double n = __builtin_rint(x * 0.63661977236758134308); const double y = x - n * 1.57079632679489661923; const double y2 = y * y;
    double s = -1.0 / 39916800.0; s = s * y2 + 1.0 / 362880.0; s = s * y2 - 1.0 / 5040.0; s = s * y2 + 1.0 / 120.0; s = s * y2 - 1.0 / 6.0; s = s * y2 + 1.0; s = s * y;
    double c = 1.0 / 479001600.0; c = c * y2 - 1.0 / 3628800.0; c = c * y2 + 1.0 / 40320.0; c = c * y2 - 1.0 / 720.0; c = c * y2 + 1.0 / 24.0; c = c * y2 - 0.5; c = c * y2 + 1.0;
    const int q = ((int)n) & 3;
    const double cc = (q == 0) ? c : (q == 1) ? -s : (q == 2) ? -c : s;
    const double ss = (q == 0) ? s : (q == 1) ? c : (q == 2) ? -s : -c;
    cs = (float)cc; sn = (float)ss;
}

DI void prep_phase(const Params& p, LAS unsigned char* lds) {
    const int t = opaque_tid(), wave = t >> 6, lane = t & 63, r = lane & 31, hh = lane >> 5; const int bid = opaque_bid();
    float* MOD = (float*)(p.ws + WS_MOD); float* KVMOD = (float*)(p.ws + WS_KVMOD); float* ROT = (float*)(p.ws + WS_ROT);
    const int gw = bid * 8 + wave;
    for (int mt = gw; mt < 640; mt += gridDim.x * 8) {
        const int gc0 = mt * 32; const float* W; int ldw; const float* bias; float* dst; int dstride;
        if (gc0 < 18432) { const int l = gc0 >= 9216 ? 1 : 0; const int j0 = gc0 - l * 9216; W = p.w_ada + (size_t)l * 1024 * 9216 + j0; ldw = 9216; bias = p.b_ada + l * 9216 + j0; dst = MOD + (size_t)l * 32 * 9216 + j0; dstride = 9216; }
        else { const int j0 = gc0 - 18432; W = p.w_kv_ada + j0; ldw = 2048; bias = p.b_kv_ada + j0; dst = KVMOD + j0; dstride = 2048; }
        f32x16 acc;
#pragma unroll
        for (int i = 0; i < 16; ++i) acc[i] = 0.f;
        const float* cp = p.c + r * 1024 + hh; const float* wp = W + (size_t)hh * ldw + r;
#pragma unroll 8
        for (int it = 0; it < 512; ++it) { const float cv = cp[2 * it]; const float a = cv / (1.0f + __expf(-cv)); const float bv = wp[(size_t)(2 * it) * ldw];
            acc = __builtin_amdgcn_mfma_f32_32x32x2f32(a, bv, acc, 0, 0, 0); }
        const float bb = bias[r];
#pragma unroll
        for (int reg = 0; reg < 16; ++reg) dst[(size_t)crow(reg, hh) * dstride + r] = acc[reg] + bb;
    }
    { const int gt = (gridDim.x - 1 - bid) * 512 + t;
      if (gt < 2048 * 16) { const int pos = gt >> 4, i = gt & 15; const float invf = __builtin_amdgcn_exp2f(-(float)i * (18.931568569324174f / 16.0f));
          const float ang = (float)pos * invf; float cs, sn; sincos_d(ang, cs, sn); ROT[gt] = cs; ROT[2048 * 16 + gt] = sn; } }
    LAS float* tile = (LAS float*)lds;
    for (int it = bid; it < 10496; it += gridDim.x) {
        const float* src; bf16_t* dst; int K, N, mode = 0, loc;
        if (it < 5632) { const int j = it / 1408; loc = it - j * 1408; src = p.w_ffn_in + (size_t)j * 1024 * 5632; dst = (bf16_t*)(p.ws + WS_WIN) + (size_t)j * 5632 * 1024; K = 1024; N = 5632; mode = 1; }
        else if (it < 8448) { const int j = (it - 5632) / 704; loc = it - 5632 - j * 704; src = p.w_ffn_out + (size_t)j * 2816 * 1024; dst = (bf16_t*)(p.ws + WS_WOUT) + (size_t)j * 1024 * 2816; K = 2816; N = 1024; }
        else if (it < 9216) { loc = it - 8448; src = p.w_qkv_a; dst = (bf16_t*)(p.ws + WS_WQKV); K = 1024; N = 3072; }
        else if (it < 9472) { loc = it - 9216; src = p.w_q_b; dst = (bf16_t*)(p.ws + WS_WQB); K = 1024; N = 1024; }
        else if (it < 9984) { loc = it - 9472; src = p.w_kv_b; dst = (bf16_t*)(p.ws + WS_WKVB); K = 1024; N = 2048; }
        else { const int j = (it - 9984) / 256; loc = it - 9984 - j * 256; src = p.w_o + (size_t)j * 1024 * 1024; dst = (bf16_t*)(p.ws + WS_WO) + (size_t)j * 1024 * 1024; K = 1024; N = 1024; }
        const int ntn = N / 64; const int tk = loc / ntn, tn = loc - tk * ntn;
        transpose_tile(tile, src, dst, K, N, mode, tk, tn);
    }
}

DI void row_phase(const float* zin, float* xout, const float* lng, const float* lnb, bf16_t* h1, const float* m1, int st1, bf16_t* h2, const float* m2, int st2) {
    const int tid = opaque_tid(); const int wave = tid >> 6, lane = tid & 63;
    const int gw = opaque_bid() * 8 + wave, nw = gridDim.x * 8;
    for (int row = gw; row < T_TOK; row += nw) {
        const int b = row >> 11; f32x4 v[4];
#pragma unroll
        for (int i = 0; i < 4; ++i) v[i] = *(const f32x4*)(zin + (size_t)row * DM + i * 256 + lane * 4);
        if (lng) {
            float s = 0.f;
#pragma unroll
            for (int i = 0; i < 4; ++i) s += (v[i][0] + v[i][1]) + (v[i][2] + v[i][3]);
#pragma unroll
            for (int o = 32; o >= 1; o >>= 1) s += __shfl_xor(s, o);
            const float mean = s * (1.0f / 1024.0f); float q = 0.f;
#pragma unroll
            for (int i = 0; i < 4; ++i) { const f32x4 d = v[i] - mean; q += (d[0] * d[0] + d[1] * d[1]) + (d[2] * d[2] + d[3] * d[3]); }
#pragma unroll
            for (int o = 32; o >= 1; o >>= 1) q += __shfl_xor(q, o);
            const float rstd = 1.0f / sqrtf(q * (1.0f / 1024.0f) + LN_EPS);
#pragma unroll
            for (int i = 0; i < 4; ++i) { const f32x4 g = *(const f32x4*)(lng + i * 256 + lane * 4), bb = *(const f32x4*)(lnb + i * 256 + lane * 4);
                v[i] = (v[i] - mean) * rstd * g + bb; *(f32x4*)(xout + (size_t)row * DM + i * 256 + lane * 4) = v[i]; }
        }
        if (h1) {
            const float* sh = m1 + (size_t)b * st1;
#pragma unroll
            for (int i = 0; i < 4; ++i) { const f32x4 a = *(const f32x4*)(sh + i * 256 + lane * 4), sc = *(const f32x4*)(sh + 1024 + i * 256 + lane * 4);
                const f32x4 h = v[i] * (sc + 1.0f) + a; u32x2 w; w.x = pk2(h[0], h[1]); w.y = pk2(h[2], h[3]); *(u32x2*)(h1 + (size_t)row * DM + i * 256 + lane * 4) = w; }
        }
        if (h2) {
            const float* sh = m2 + (size_t)b * st2;
#pragma unroll
            for (int i = 0; i < 4; ++i) { const f32x4 a = *(const f32x4*)(sh + i * 256 + lane * 4), sc = *(const f32x4*)(sh + 1024 + i * 256 + lane * 4);
                const f32x4 h = v[i] * (sc + 1.0f) + a; u32x2 w; w.x = pk2(h[0], h[1]); w.y = pk2(h[2], h[3]); *(u32x2*)(h2 + (size_t)row * DM + i * 256 + lane * 4) = w; }
        }
    }
}

DI f32x16 mfma32(bf16x8 a, bf16x8 b, f32x16 c) { return __builtin_amdgcn_mfma_f32_32x32x16_bf16(a, b, c, 0, 0, 0); }
DI bf16x8 pack8(const f32x16& x, int s) {
    u32x4 p; p.x = pk2(x[8 * s], x[8 * s + 1]); p.y = pk2(x[8 * s + 2], x[8 * s + 3]); p.z = pk2(x[8 * s + 4], x[8 * s + 5]); p.w = pk2(x[8 * s + 6], x[8 * s + 7]);
    return __builtin_bit_cast(bf16x8, p);
}
DI bf16x8 ldg16(const char* base, unsigned voff) { return *(const bf16x8*)(base + voff); }
DI s16x4 ldg8(const char* base, unsigned voff) { return *(const s16x4*)(base + voff); }
DI void pv_step(f32x16 (&O)[4], const f32x16& pt, const char* vb, unsigned vvoff) {
#pragma unroll
    for (int s = 0; s < 2; ++s) { const bf16x8 pf = pack8(pt, s);
#pragma unroll
        for (int dt = 0; dt < 4; ++dt) { const char* vp = vb + (size_t)(32 * dt) * T_TOK * 2 + 32 * s;
            const s16x4 lo = ldg8(vp, vvoff), hi = ldg8(vp + 16, vvoff);
            const bf16x8 vf = __builtin_shufflevector(lo, hi, 0, 1, 2, 3, 4, 5, 6, 7);
            O[dt] = mfma32(vf, pf, O[dt]); } }
}
DI void store_ot(const f32x16 (&O)[4], float inv, bf16_t* orow, int hh) {
#pragma unroll
    for (int dt = 0; dt < 4; ++dt)
#pragma unroll
        for (int rq = 0; rq < 4; ++rq) { u32x2 w; w.x = pk2(O[dt][4 * rq] * inv, O[dt][4 * rq + 1] * inv); w.y = pk2(O[dt][4 * rq + 2] * inv, O[dt][4 * rq + 3] * inv);
            *(u32x2*)(orow + 32 * dt + 8 * rq + 4 * hh) = w; }
}

constexpr int MK_PITCH = 272, MV_PITCH = 136, MK_BYTES = 64 * MK_PITCH, MV_BYTES = 128 * MV_PITCH;
DI void moba_phase(const bf16_t* __restrict__ Q, const bf16_t* __restrict__ Kb, const bf16_t* __restrict__ VT, const float* __restrict__ kpart, bf16_t* __restrict__ out, LAS unsigned char* lds) {
    const int tid = opaque_tid(); const int wave = __builtin_amdgcn_readfirstlane(tid >> 6), lane = tid & 63, r = lane & 31, hh = lane >> 5;
    const float c2 = 0.08838834764831845f * 1.4426950408889634f;
    const unsigned kvoff = (unsigned)(r * DM + 8 * hh) * 2u;
    const unsigned kst_off = (unsigned)((tid >> 3) * DM * 2 + (tid & 7) * 16), kst_lds = (unsigned)((tid >> 3) * MK_PITCH + (tid & 7) * 16);
    const unsigned vst_off = (unsigned)((tid >> 2) * T_TOK * 2 + (tid & 3) * 16), vst_lds = (unsigned)((tid >> 2) * MV_PITCH + (tid & 3) * 16);
    const unsigned kfr = (unsigned)(r * MK_PITCH + 16 * hh), vfr = (unsigned)(r * MV_PITCH + 8 * hh);
    LAS unsigned char* ldsK = lds; LAS unsigned char* ldsV = lds + 2 * MK_BYTES;
    for (int bh = opaque_bid(); bh < NB * NH; bh += gridDim.x) {
        const int b = bh >> 3, head = bh & 7;
        const char* Kh = (const char*)(Kb + (size_t)b * SEQ * DM + head * 128);
        const char* Vh = (const char*)(VT + (size_t)(head * 128) * T_TOK + (size_t)b * SEQ);
        for (int cur = 0; cur < 8; ++cur) {
            const int g = (wave + cur) & 7; const int qpos = 256 * cur + 32 * g + r;
            const char* qb = (const char*)(Q + ((size_t)b * SEQ + 256 * cur + 32 * g) * DM + head * 128);
            bf16x8 qf[8];
#pragma unroll
            for (int ks = 0; ks < 8; ++ks) qf[ks] = ldg16(qb + 32 * ks, kvoff);
            unsigned selmask = (1u << cur) - 1u;
            if (cur > 3) {
                float v1 = -3.0e38f, v2 = -3.0e38f, v3 = -3.0e38f; int i1 = 0, i2 = 0, i3 = 0;
#pragma unroll 1
                for (int kb = 0; kb < cur; ++kb) {
                    const float* kp = kpart + (size_t)((b * 8 + kb) * 2) * DM + head * 128 + 8 * hh; float acc = 0.f;
#pragma unroll
                    for (int ks = 0; ks < 8; ++ks) { const f32x4 a0 = *(const f32x4*)(kp + 16 * ks), a1 = *(const f32x4*)(kp + 16 * ks + 4), b0 = *(const f32x4*)(kp + DM + 16 * ks), b1 = *(const f32x4*)(kp + DM + 16 * ks + 4);
                        const f32x4 k0 = a0 + b0, k1 = a1 + b1;
#pragma unroll
                        for (int j = 0; j < 4; ++j) { acc += bf2f(qf[ks][j]) * k0[j]; acc += bf2f(qf[ks][4 + j]) * k1[j]; }
                        if (ks & 1) asm volatile("" ::: "memory"); }
                    acc += __shfl_xor(acc, 32);
                    const bool g1 = acc > v1, g2 = acc > v2, g3 = acc > v3;
                    v3 = g2 ? v2 : (g3 ? acc : v3); i3 = g2 ? i2 : (g3 ? kb : i3);
                    v2 = g1 ? v1 : (g2 ? acc : v2); i2 = g1 ? i1 : (g2 ? kb : i2);
                    v1 = g1 ? acc : v1; i1 = g1 ? kb : i1;
                }
                selmask = (1u << i1) | (1u << i2) | (1u << i3);
            }
            float m = -1.0e30f, lsum = 0.f; f32x16 O[4];
#pragma unroll
            for (int dt = 0; dt < 4; ++dt)
#pragma unroll
                for (int i = 0; i < 16; ++i) O[dt][i] = 0.f;
            const int ntiles = 4 * (cur + 1);
            {
                const bf16x8 k0 = ldg16(Kh, kst_off), k1 = ldg16(Kh + 128, kst_off), v0 = ldg16(Vh, vst_off), v1 = ldg16(Vh + 64, vst_off);
                *(LAS bf16x8*)(ldsK + kst_lds) = k0; *(LAS bf16x8*)(ldsK + kst_lds + 128) = k1;
                const u32x4 w0 = __builtin_bit_cast(u32x4, v0), w1 = __builtin_bit_cast(u32x4, v1);
                *(LAS u32x2*)(ldsV + vst_lds) = (u32x2){w0.x, w0.y}; *(LAS u32x2*)(ldsV + vst_lds + 8) = (u32x2){w0.z, w0.w};
                *(LAS u32x2*)(ldsV + vst_lds + 64) = (u32x2){w1.x, w1.y}; *(LAS u32x2*)(ldsV + vst_lds + 72) = (u32x2){w1.z, w1.w};
            }
            __syncthreads();
            for (int t = 0; t < ntiles; ++t) {
                const int buf = t & 1; const bool pf = (t + 1 < ntiles);
                bf16x8 pk0, pk1, pv0, pv1;
                if (pf) { const char* kn = Kh + (size_t)(64 * (t + 1)) * DM * 2; const char* vn = Vh + (size_t)(64 * (t + 1)) * 2;
                    pk0 = ldg16(kn, kst_off); pk1 = ldg16(kn + 128, kst_off); pv0 = ldg16(vn, vst_off); pv1 = ldg16(vn + 64, vst_off); }
                const int kb = t >> 2, kbase = 64 * t; const bool own = (kb == cur); const bool lsel = own || (((selmask >> kb) & 1u) != 0u);
                const bool need = own ? (kbase <= 256 * cur + 32 * g + 31) : (__ballot(lsel) != 0ull);
                if (need) {
                    const LAS unsigned char* kt = ldsK + buf * MK_BYTES + kfr; const LAS unsigned char* vt = ldsV + buf * MV_BYTES + vfr;
                    f32x16 s0, s1;
#pragma unroll
                    for (int i = 0; i < 16; ++i) { s0[i] = 0.f; s1[i] = 0.f; }
#pragma unroll
                    for (int ks = 0; ks < 8; ++ks) { s0 = mfma32(*(const LAS bf16x8*)(kt + 32 * ks), qf[ks], s0); s1 = mfma32(*(const LAS bf16x8*)(kt + 32 * MK_PITCH + 32 * ks), qf[ks], s1); }
                    float mt = -3.0e30f;
#pragma unroll
                    for (int reg = 0; reg < 16; ++reg) { const int key0 = kbase + crow(reg, hh);
                        const bool v0 = lsel && (key0 <= qpos), v1 = lsel && (key0 + 32 <= qpos);
                        s0[reg] = v0 ? s0[reg] * c2 : -3.0e30f; s1[reg] = v1 ? s1[reg] * c2 : -3.0e30f; mt = fmaxf(mt, fmaxf(s0[reg], s1[reg])); }
                    mt = fmaxf(mt, __shfl_xor(mt, 32));
                    const float mn = fmaxf(m, mt); const float alpha = __builtin_amdgcn_exp2f(m - mn); m = mn;
                    float ps = 0.f;
#pragma unroll
                    for (int reg = 0; reg < 16; ++reg) { s0[reg] = __builtin_amdgcn_exp2f(s0[reg] - mn); s1[reg] = __builtin_amdgcn_exp2f(s1[reg] - mn); ps += s0[reg] + s1[reg]; }
                    lsum = lsum * alpha + ps;
                    if (__ballot(alpha != 1.0f) != 0ull) {
#pragma unroll
                        for (int dt = 0; dt < 4; ++dt) O[dt] = O[dt] * alpha; }
#pragma unroll
                    for (int sub = 0; sub < 2; ++sub)
#pragma unroll
                        for (int s = 0; s < 2; ++s) { const bf16x8 pf8 = pack8(sub ? s1 : s0, s);
#pragma unroll
                            for (int dt = 0; dt < 4; ++dt) { const LAS unsigned char* vp = vt + dt * 32 * MV_PITCH + sub * 64 + 32 * s;
                                const s16x4 lo = *(const LAS s16x4*)vp, hi = *(const LAS s16x4*)(vp + 16);
                                O[dt] = mfma32(__builtin_shufflevector(lo, hi, 0, 1, 2, 3, 4, 5, 6, 7), pf8, O[dt]); } }
                }
                if (pf) { LAS unsigned char* kd = ldsK + (buf ^ 1) * MK_BYTES + kst_lds; LAS unsigned char* vd = ldsV + (buf ^ 1) * MV_BYTES + vst_lds;
                    *(LAS bf16x8*)kd = pk0; *(LAS bf16x8*)(kd + 128) = pk1;
                    const u32x4 w0 = __builtin_bit_cast(u32x4, pv0), w1 = __builtin_bit_cast(u32x4, pv1);
                    *(LAS u32x2*)vd = (u32x2){w0.x, w0.y}; *(LAS u32x2*)(vd + 8) = (u32x2){w0.z, w0.w};
                    *(LAS u32x2*)(vd + 64) = (u32x2){w1.x, w1.y}; *(LAS u32x2*)(vd + 72) = (u32x2){w1.z, w1.w}; }
                __syncthreads();
            }
            lsum += __shfl_xor(lsum, 32);
            store_ot(O, 1.0f / lsum, out + ((size_t)b * SEQ + qpos) * DM + head * 128, hh);
        }
    }
}

DI void sb_phase(const bf16_t* __restrict__ Q, const bf16_t* __restrict__ Kb, const bf16_t* __restrict__ VT, bf16_t* __restrict__ out) {
    const int tid = opaque_tid(); const int wave = __builtin_amdgcn_readfirstlane(tid >> 6), lane = tid & 63, r = lane & 31, hh = lane >> 5;
    const float scale = 0.08838834764831845f;
    const unsigned kvoff = (unsigned)(r * DM + 8 * hh) * 2u, vvoff = (unsigned)(r * T_TOK + 4 * hh) * 2u;
    for (int bh = opaque_bid(); bh < NB * NH; bh += gridDim.x) {
        const int b = bh >> 3, head = bh & 7;
        const bf16_t* Kh = Kb + (size_t)b * SEQ * DM + head * 128;
        const bf16_t* Vh = VT + (size_t)(head * 128) * T_TOK + (size_t)b * SEQ;
        for (int i8 = 0; i8 < 8; ++i8) {
            const int t0 = 32 * (wave + 8 * i8); const int qpos = t0 + r;
            const char* qb = (const char*)(Q + ((size_t)b * SEQ + t0) * DM + head * 128);
            bf16x8 qf[8];
#pragma unroll
            for (int ks = 0; ks < 8; ++ks) qf[ks] = ldg16(qb + 32 * ks, kvoff);
            float R = 0.f; f32x16 O[4];
#pragma unroll
            for (int dt = 0; dt < 4; ++dt)
#pragma unroll
                for (int i = 0; i < 16; ++i) O[dt][i] = 0.f;
            for (int kbase = t0; kbase >= 0; kbase -= 32) {
                f32x16 s;
#pragma unroll
                for (int i = 0; i < 16; ++i) s[i] = 0.f;
                const char* kp0 = (const char*)(Kh + (size_t)kbase * DM);
#pragma unroll
                for (int ks = 0; ks < 8; ++ks) s = mfma32(ldg16(kp0 + 32 * ks, kvoff), qf[ks], s);
                float L[16];
#pragma unroll
                for (int reg = 0; reg < 16; ++reg) { const int key = kbase + crow(reg, hh); const bool valid = key < qpos; const float z = s[reg] * scale;
                    const float sp = fmaxf(z, 0.f) + __logf(1.0f + __expf(-fabsf(z)));
                    L[reg] = valid ? sp : 0.f; s[reg] = valid ? z : -1.0e30f; }
                float Gt[4], Go[4];
#pragma unroll
                for (int g4 = 0; g4 < 4; ++g4) { L[4 * g4 + 2] += L[4 * g4 + 3]; L[4 * g4 + 1] += L[4 * g4 + 2]; L[4 * g4] += L[4 * g4 + 1]; Gt[g4] = L[4 * g4]; }
#pragma unroll
                for (int g4 = 0; g4 < 4; ++g4) Go[g4] = __shfl_xor(Gt[g4], 32);
                float run = R;
#pragma unroll
                for (int g4 = 3; g4 >= 0; --g4) { const float after = run + (hh == 0 ? Go[g4] : 0.f);
#pragma unroll
                    for (int i = 0; i < 4; ++i) s[4 * g4 + i] = __expf(s[4 * g4 + i] - (after + L[4 * g4 + i]));
                    run += Gt[g4] + Go[g4]; }
                R = run;
                pv_step(O, s, (const char*)(Vh + kbase), vvoff);
                if (__ballot(R <= 104.0f) == 0ull) break;
            }
            store_ot(O, 1.0f, out + ((size_t)b * SEQ + qpos) * DM + head * 128, hh);
        }
    }
}

enum { PH_PREP = 0, PH_ROW, PH_SWIGLU, PH_Z, PH_QKROT, PH_BF16, PH_MOBA, PH_SB };
constexpr int NPH = 25;
#ifndef PROBE_DUP
#define PROBE_DUP -1
#endif
#ifndef PROBE_DUP2
#define PROBE_DUP2 -1
#endif

__global__ void __launch_bounds__(512) fwd_megakernel(Params p) {
    extern __shared__ __attribute__((aligned(16))) unsigned char smem[];
    LAS unsigned char* lds = (LAS unsigned char*)smem;
    cg::grid_group grid = cg::this_grid();
    unsigned char* ws = p.ws;
    bf16_t* HB = (bf16_t*)(ws + WS_HB); bf16_t* QB = (bf16_t*)(ws + WS_QB); bf16_t* KB = (bf16_t*)(ws + WS_KB); bf16_t* VT = (bf16_t*)(ws + WS_VT); bf16_t* ACT = (bf16_t*)(ws + WS_ACT);
    const bf16_t* WIN = (const bf16_t*)(ws + WS_WIN); const bf16_t* WOUT = (const bf16_t*)(ws + WS_WOUT); const bf16_t* WQKV = (const bf16_t*)(ws + WS_WQKV);
    const bf16_t* WQB = (const bf16_t*)(ws + WS_WQB); const bf16_t* WKVB = (const bf16_t*)(ws + WS_WKVB); const bf16_t* WO = (const bf16_t*)(ws + WS_WO);
    const float* MOD = (const float*)(ws + WS_MOD); const float* KVMOD = (const float*)(ws + WS_KVMOD); const float* ROT = (const float*)(ws + WS_ROT); float* KPART = (float*)(ws + WS_KPART);
    float* X = p.out;

    for (int ph = 0; ph < NPH; ++ph) {
        int type = PH_PREP, sync = 1;
        const bf16_t* gA = nullptr; const bf16_t* gB = nullptr; int gM = T_TOK, gN = 0, gK = DM; bf16_t* gO = nullptr; int gld = DM;
        const float* zres = X; const float* zgate = nullptr; float zw = 0.5f;
        const float* rin = X; float* rout = X; const float* rg = nullptr; const float* rb = nullptr; bf16_t* rh1 = nullptr; const float* rm1 = nullptr; int rs1 = 9216; bf16_t* rh2 = nullptr; const float* rm2 = nullptr; int rs2 = 2048;
        const int l = ph >= 13 ? 1 : 0;
        const float* modl = MOD + (size_t)l * 32 * 9216;
        switch (ph) {
            case 0: type = PH_PREP; break;
            case 1: type = PH_ROW; rin = p.x; rh1 = HB; rm1 = MOD; break;
            case 2: case 10: case 15: case 22: { type = PH_SWIGLU; const int s = (ph == 2 || ph == 15) ? 0 : 1; gA = HB; gB = WIN + (size_t)(l * 2 + s) * 5632 * 1024; gN = 5632; gK = DM; gO = ACT; } break;
            case 3: case 11: case 16: case 23: { type = PH_Z; const int s = (ph == 3 || ph == 16) ? 0 : 1; gA = ACT; gB = WOUT + (size_t)(l * 2 + s) * 1024 * 2816; gN = DM; gK = DFF; zres = (ph == 3) ? p.x : X; zgate = modl + (s ? 8 : 2) * 1024; zw = 0.5f; } break;
            case 4: case 17: type = PH_ROW; rg = p.ln_g + (l * 3 + 0) * 1024; rb = p.ln_b + (l * 3 + 0) * 1024; rh1 = HB; rm1 = modl + 3 * 1024; break;
            case 5: type = PH_QKROT; gA = HB; gB = WQKV; gN = 2048; sync = 0; break;
            case 6: type = PH_BF16; gA = WQKV + (size_t)2048 * 1024; gB = HB; gM = DM; gN = T_TOK; gO = VT; gld = T_TOK; break;
            case 7: type = PH_MOBA; break;
            case 8: case 20: type = PH_Z; gA = HB; gB = WO + (size_t)l * 1024 * 1024; gN = DM; gK = DM; zgate = modl + 5 * 1024; zw = 1.0f; break;
            case 9: case 21: type = PH_ROW; rg = p.ln_g + (l * 3 + 1) * 1024; rb = p.ln_b + (l * 3 + 1) * 1024; rh1 = HB; rm1 = modl + 6 * 1024; break;
            case 12: type = PH_ROW; rg = p.ln_g + 2 * 1024; rb = p.ln_b + 2 * 1024; rh1 = HB; rm1 = MOD + (size_t)32 * 9216; rh2 = QB; rm2 = KVMOD; break;
            case 13: type = PH_BF16; gA = QB; gB = WKVB; gN = DM; gO = KB; gld = DM; sync = 0; break;
            case 14: type = PH_BF16; gA = WKVB + (size_t)1024 * 1024; gB = QB; gM = DM; gN = T_TOK; gO = VT; gld = T_TOK; sync = 0; break;
            case 18: type = PH_BF16; gA = HB; gB = WQB; gN = DM; gO = QB; gld = DM; break;
            case 19: type = PH_SB; break;
            case 24: type = PH_ROW; rg = p.ln_g + 5 * 1024; rb = p.ln_b + 5 * 1024; break;
            default: break;
        }
        const int reps = (ph == PROBE_DUP || ph == PROBE_DUP2) ? 2 : 1;
        for (int rep = 0; rep < reps; ++rep) {
        pg8::Gemm gm; gm.A = gA; gm.Bt = gB; gm.M = gM; gm.N = gN; gm.K = gK;
        pg8::StaticOrder so; so.init(gM, gN > 0 ? gN : 256, gridDim.x, opaque_bid());
        if (type == PH_PREP) prep_phase(p, lds);
        else if (type == PH_ROW) row_phase(rin, rout, rg, rb, rh1, rm1, rs1, rh2, rm2, rs2);
        else if (type == PH_SWIGLU) { pg8::EpiSwiglu e; e.O = gO; pg8::gemm_phase(lds, gm, so, e); }
        else if (type == PH_Z) { pg8::EpiZ e; e.res = zres; e.out = X; e.gate = zgate; e.w = zw; pg8::gemm_phase(lds, gm, so, e); }
        else if (type == PH_QKROT) { pg8::EpiQKRot e; e.Q = QB; e.K = KB; e.rot = ROT; e.kpart = KPART; pg8::gemm_phase(lds, gm, so, e); }
        else if (type == PH_BF16) { pg8::EpiBf16 e; e.O = gO; e.ldc = gld; pg8::gemm_phase(lds, gm, so, e); }
        else if (type == PH_MOBA) moba_phase(QB, KB, VT, KPART, HB, lds);
        else if (type == PH_SB) sb_phase(QB, KB, VT, HB);
        if (sync || rep + 1 < reps) grid.sync();
        }
    }
}

constexpr int LDS_BYTES = pg8::STAGE_BYTES;

extern "C" void kernel_launch(void* const* d_in, const int* in_sizes, int n_in, void* d_out, int out_size, void* d_ws, size_t ws_size, hipStream_t stream) {
    static int grid_blocks = 0;
    if (grid_blocks == 0) {
        if (n_in != 14 || out_size != T_TOK * DM || ws_size < WS_END) { fprintf(stderr, "kernel_launch: unexpected shapes (n_in %d out %d ws %zu need %zu)\n", n_in, out_size, ws_size, (size_t)WS_END); grid_blocks = -1; return; }
        int dev = 0, cus = 0, per_cu = 0;
        hipGetDevice(&dev);
        hipDeviceGetAttribute(&cus, hipDeviceAttributeMultiprocessorCount, dev);
        if (hipFuncSetAttribute((const void*)fwd_megakernel, hipFuncAttributeMaxDynamicSharedMemorySize, LDS_BYTES) != hipSuccess) { fprintf(stderr, "kernel_launch: hipFuncSetAttribute failed\n"); grid_blocks = -1; return; }
        hipOccupancyMaxActiveBlocksPerMultiprocessor(&per_cu, (const void*)fwd_megakernel, 512, LDS_BYTES);
        if (per_cu < 1) { fprintf(stderr, "kernel_launch: occupancy query says %d blocks/CU\n", per_cu); per_cu = 1; }
        (void)hipGetLastError();
        grid_blocks = cus;
    }
    if (grid_blocks < 0) return;
    Params p{};
    p.x = (const float*)d_in[0]; p.c = (const float*)d_in[1]; p.w_ada = (const float*)d_in[2]; p.b_ada = (const float*)d_in[3]; p.ln_g = (const float*)d_in[4]; p.ln_b = (const float*)d_in[5];
    p.w_ffn_in = (const float*)d_in[6]; p.w_ffn_out = (const float*)d_in[7]; p.w_qkv_a = (const float*)d_in[8]; p.w_q_b = (const float*)d_in[9]; p.w_kv_ada = (const float*)d_in[10]; p.b_kv_ada = (const float*)d_in[11];
    p.w_kv_b = (const float*)d_in[12]; p.w_o = (const float*)d_in[13]; p.out = (float*)d_out; p.ws = (unsigned char*)d_ws;
    void* args[] = {&p};
    hipError_t e = hipLaunchCooperativeKernel((const void*)fwd_megakernel, dim3(grid_blocks), dim3(512), args, LDS_BYTES, stream);
    if (e != hipSuccess) fprintf(stderr, "cooperative launch failed: %s (grid %d)\n", hipGetErrorString(e), grid_blocks);
}
```
